# Optimizing an MI355X kernel written in HIP

```python
import math
import jax, jax.numpy as jnp
from jax import lax
import numpy as np

D_MODEL = 2048
BATCH = 4
SEQ = 8192
DEPTH = 1
DEC_BATCH = 8
DEC_SEQ = 64
PAST_LEN = 2048

CHUNK = 64
NORM_EPS = 1e-6
MLA_HEADS = 16
Q_LORA = 512
KV_LORA = 512
QK_NOPE = 128
QK_ROPE = 64
V_HEAD = 128
ROPE_THETA = 10000.0
Q_BLOCK = 128
SSD_INNER = 2 * D_MODEL
SSD_HEADDIM = 64
SSD_HEADS = SSD_INNER // SSD_HEADDIM
SSD_GROUPS = 8
SSD_STATE = 128
SSD_CONV = 4
SSD_CHUNK = CHUNK
CONV_DIM = SSD_INNER + 2 * SSD_GROUPS * SSD_STATE
D_FF = 5632
FFN_CONV = 3
OFF_Q = 0
OFF_KV = OFF_Q + Q_LORA
OFF_Z = OFF_KV + KV_LORA + QK_ROPE
OFF_XBC = OFF_Z + SSD_INNER
OFF_DT = OFF_XBC + CONV_DIM
OFF_GATE = OFF_DT + SSD_HEADS
IN_DIM = OFF_GATE + 2 * D_MODEL

kernel_name = 'hybrid_mla_ssd_convffn_stream_step'


def rmsnorm(x, g):
    xf = x.astype(jnp.float32)
    xf = xf * lax.rsqrt(jnp.mean(xf * xf, axis=-1, keepdims=True) + NORM_EPS)
    return (xf * g.astype(jnp.float32)).astype(x.dtype)


def rope(x, pos):
    half = x.shape[-1] // 2
    inv = ROPE_THETA ** (-jnp.arange(half, dtype=jnp.float32) / half)
    ang = pos.astype(jnp.float32)[:, None] * inv[None, :]
    shape = (1, pos.shape[0]) + (1,) * (x.ndim - 3) + (half,)
    cos = jnp.cos(ang).reshape(shape)
    sin = jnp.sin(ang).reshape(shape)
    xf = x.astype(jnp.float32)
    x1, x2 = xf[..., :half], xf[..., half:]
    return jnp.concatenate([x1 * cos - x2 * sin, x1 * sin + x2 * cos], axis=-1).astype(x.dtype)


def causal_dwconv(x, hist, w, b):
    K = w.shape[0]
    L = x.shape[1]
    xp = jnp.concatenate([hist.astype(x.dtype), x], axis=1)
    y = b + xp[:, 0:L] * w[0]
    for k in range(1, K):
        y = y + xp[:, k:k + L] * w[k]
    return y, xp[:, -(K - 1):]


def mla_queries(cq, q_norm_g, w_uq, pos):
    q = jnp.einsum('blr,rhd->blhd', rmsnorm(cq, q_norm_g), w_uq)
    return q[..., :QK_NOPE], rope(q[..., QK_NOPE:], pos)


def mla_latents(kv, kv_norm_g, pos):
    return rmsnorm(kv[..., :KV_LORA], kv_norm_g), rope(kv[..., KV_LORA:], pos)


def mla_expand(ckv, w_ukv):
    kvh = jnp.einsum('bsr,rhd->bshd', ckv, w_ukv)
    return kvh[..., :QK_NOPE], kvh[..., QK_NOPE:]


def mla_attend(qn, qp, kn, kp, v, mask):
    scale = (QK_NOPE + QK_ROPE) ** -0.5
    s = (jnp.einsum('bqhd,bkhd->bhqk', qn, kn, preferred_element_type=jnp.float32)
         + jnp.einsum('bqhr,bkr->bhqk', qp, kp, preferred_element_type=jnp.float32)) * scale
    if mask is not None:
        s = jnp.where(mask, s, -jnp.inf)
    p = jax.nn.softmax(s, axis=-1).astype(v.dtype)
    return jnp.einsum('bhqk,bkhd->bqhd', p, v)


def mla_prompt_attention(qn, qp, kn, kp, v):
    b, S = qn.shape[:2]
    nb = S // Q_BLOCK
    qn_b = jnp.moveaxis(qn.reshape(b, nb, Q_BLOCK, MLA_HEADS, QK_NOPE), 1, 0)
    qp_b = jnp.moveaxis(qp.reshape(b, nb, Q_BLOCK, MLA_HEADS, QK_ROPE), 1, 0)
    kchunk = jnp.arange(S) // CHUNK

    def blk(args):
        i, qn_i, qp_i = args
        qchunk = (i * Q_BLOCK + jnp.arange(Q_BLOCK)) // CHUNK
        mask = kchunk[None, :] <= qchunk[:, None]
        return mla_attend(qn_i, qp_i, kn, kp, v, mask)

    out = lax.map(blk, (jnp.arange(nb), qn_b, qp_b))
    return jnp.moveaxis(out, 0, 1).reshape(b, S, MLA_HEADS, V_HEAD)


def ssd_scan(x, dt, A, Bm, Cm, h0):
    f32 = jnp.float32
    b, L = x.shape[:2]
    Q = SSD_CHUNK if L % SSD_CHUNK == 0 else L
    nc = L // Q
    Hg = SSD_HEADS // SSD_GROUPS
    xdt = (x.astype(f32) * dt[..., None]).reshape(b, nc, Q, SSD_GROUPS, Hg, SSD_HEADDIM)
    a = (dt * A).reshape(b, nc, Q, SSD_GROUPS, Hg)
    Bc = Bm.astype(f32).reshape(b, nc, Q, SSD_GROUPS, SSD_STATE)
    Cc = Cm.astype(f32).reshape(b, nc, Q, SSD_GROUPS, SSD_STATE)
    xs = (jnp.moveaxis(xdt, 1, 0), jnp.moveaxis(a, 1, 0), jnp.moveaxis(Bc, 1, 0), jnp.moveaxis(Cc, 1, 0))
    causal = jnp.tril(jnp.ones((Q, Q), dtype=bool))[None, :, :, None, None]

    def step(h, inp):
        xc, ac, bc, cc = inp
        acum = jnp.cumsum(ac, axis=1)
        seg = acum[:, :, None] - acum[:, None, :]
        Lm = jnp.exp(jnp.where(causal, seg, -jnp.inf))
        cb = jnp.einsum('bign,bjgn->bijg', cc, bc)
        y = jnp.einsum('bijg,bijgh,bjghp->bighp', cb, Lm, xc)
        y = y + jnp.einsum('bign,bghpn->bighp', cc, h) * jnp.exp(acum)[..., None]
        decay = jnp.exp(acum[:, -1:] - acum)
        h = h * jnp.exp(acum[:, -1])[..., None, None] + jnp.einsum('bjgn,bjgh,bjghp->bghpn', bc, decay, xc)
        return h, y

    h_init = h0.astype(f32).reshape(b, SSD_GROUPS, Hg, SSD_HEADDIM, SSD_STATE)
    h, ys = lax.scan(step, h_init, xs)
    y = jnp.moveaxis(ys, 0, 1).reshape(b, L, SSD_HEADS, SSD_HEADDIM)
    return y, h.reshape(b, SSD_HEADS, SSD_HEADDIM, SSD_STATE)


def encoder_layer(x, pos, ckv_past, kpe_past, sconv_hist, ssd_h0, fconv_hist, p):
    b, L, _ = x.shape
    f32 = jnp.float32
    u = rmsnorm(x, p['pre_mix_g'])
    proj = jnp.einsum('bld,de->ble', u, p['w_in'])

    qn, qp = mla_queries(proj[..., OFF_Q:OFF_KV], p['q_norm_g'], p['w_uq'], pos)
    ckv, kpe = mla_latents(proj[..., OFF_KV:OFF_Z], p['kv_norm_g'], pos)
    if ckv_past is None:
        kn, v = mla_expand(ckv, p['w_ukv'])
        att = mla_prompt_attention(qn, qp, kn, kpe, v)
    else:
        ckv_all = jnp.concatenate([ckv_past.astype(ckv.dtype), ckv], axis=1)
        kpe_all = jnp.concatenate([kpe_past.astype(kpe.dtype), kpe], axis=1)
        kn, v = mla_expand(ckv_all, p['w_ukv'])
        att = mla_attend(qn, qp, kn, kpe_all, v, None)
    o_mla = att.reshape(b, L, MLA_HEADS * V_HEAD) @ p['w_o_mla']

    z = proj[..., OFF_Z:OFF_XBC]
    xbc, sconv_tail = causal_dwconv(proj[..., OFF_XBC:OFF_DT], sconv_hist, p['ssd_conv_w'], p['ssd_conv_b'])
    xbc = jax.nn.silu(xbc)
    xs = xbc[..., :SSD_INNER].reshape(b, L, SSD_HEADS, SSD_HEADDIM)
    Bm = xbc[..., SSD_INNER:SSD_INNER + SSD_GROUPS * SSD_STATE].reshape(b, L, SSD_GROUPS, SSD_STATE)
    Cm = xbc[..., SSD_INNER + SSD_GROUPS * SSD_STATE:].reshape(b, L, SSD_GROUPS, SSD_STATE)
    dt = jax.nn.softplus(proj[..., OFF_DT:OFF_GATE].astype(f32) + p['ssd_dt_bias'].astype(f32))
    A = -jnp.exp(p['ssd_A_log'].astype(f32))
    y, h_new = ssd_scan(xs, dt, A, Bm, Cm, ssd_h0)
    y = y + xs.astype(f32) * p['ssd_D'].astype(f32)[:, None]
    y = y.reshape(b, L, SSD_INNER) * jax.nn.silu(z.astype(f32))
    yg = y.reshape(b, L, SSD_GROUPS, SSD_INNER // SSD_GROUPS)
    yg = yg * lax.rsqrt(jnp.mean(yg * yg, axis=-1, keepdims=True) + NORM_EPS)
    y = (yg.reshape(b, L, SSD_INNER) * p['ssd_norm_g'].astype(f32)).astype(x.dtype)
    o_ssd = y @ p['w_o_ssd']

    g_a = jax.nn.sigmoid(proj[..., OFF_GATE:OFF_GATE + D_MODEL])
    g_b = jax.nn.sigmoid(proj[..., OFF_GATE + D_MODEL:])
    mix = (g_a * o_mla + g_b * o_ssd) @ p['w_out']
    x = x + rmsnorm(mix, p['post_mix_g'])

    up = rmsnorm(x, p['pre_ffn_g']) @ p['w_up']
    upc, fconv_tail = causal_dwconv(up, fconv_hist, p['ffn_conv_w'], p['ffn_conv_b'])
    hdn = jax.nn.silu(upc[..., :D_FF]) * upc[..., D_FF:]
    x = x + rmsnorm(hdn @ p['w_down'], p['post_ffn_g'])
    return x, ckv, kpe, sconv_tail, h_new.astype(x.dtype), fconv_tail


def setup_inputs(seed: int = 0) -> dict:
    key = jax.random.key(seed)
    ks = iter(jax.random.split(key, 40))
    f32 = jnp.float32

    def nrm(shape, scale=1.0):
        return jax.random.normal(next(ks), shape, f32) * scale

    def gain(n):
        return 1.0 + 0.02 * nrm((DEPTH, n))

    dt0 = jnp.exp(jax.random.uniform(next(ks), (DEPTH, SSD_HEADS), f32, math.log(1e-3), math.log(1e-1)))
    dt_bias = dt0 + jnp.log(-jnp.expm1(-dt0))
    a_log = jnp.log(jax.random.uniform(next(ks), (DEPTH, SSD_HEADS), f32, 1.0, 16.0))
    return {
        'x_prompt': nrm((BATCH, SEQ, D_MODEL)),
        'x_sample': nrm((DEC_BATCH, DEC_SEQ, D_MODEL)),
        'cache_mla_ckv': nrm((DEPTH, DEC_BATCH, PAST_LEN, KV_LORA)),
        'cache_mla_kpe': nrm((DEPTH, DEC_BATCH, PAST_LEN, QK_ROPE)),
        'state_ssd_conv': nrm((DEPTH, DEC_BATCH, SSD_CONV - 1, CONV_DIM)),
        'state_ssd': nrm((DEPTH, DEC_BATCH, SSD_HEADS, SSD_HEADDIM, SSD_STATE), 0.1),
        'state_ffn_conv': nrm((DEPTH, DEC_BATCH, FFN_CONV - 1, 2 * D_FF)),
        'pre_mix_g': gain(D_MODEL),
        'w_in': nrm((DEPTH, D_MODEL, IN_DIM), D_MODEL ** -0.5),
        'q_norm_g': gain(Q_LORA),
        'w_uq': nrm((DEPTH, Q_LORA, MLA_HEADS, QK_NOPE + QK_ROPE), Q_LORA ** -0.5),
        'kv_norm_g': gain(KV_LORA),
        'w_ukv': nrm((DEPTH, KV_LORA, MLA_HEADS, QK_NOPE + V_HEAD), KV_LORA ** -0.5),
        'ssd_conv_w': nrm((DEPTH, SSD_CONV, CONV_DIM), SSD_CONV ** -0.5),
        'ssd_conv_b': nrm((DEPTH, CONV_DIM), 0.02),
        'ssd_dt_bias': dt_bias,
        'ssd_A_log': a_log,
        'ssd_D': 1.0 + 0.1 * nrm((DEPTH, SSD_HEADS)),
        'ssd_norm_g': gain(SSD_INNER),
        'w_o_mla': nrm((DEPTH, MLA_HEADS * V_HEAD, D_MODEL), (MLA_HEADS * V_HEAD) ** -0.5),
        'w_o_ssd': nrm((DEPTH, SSD_INNER, D_MODEL), SSD_INNER ** -0.5),
        'w_out': nrm((DEPTH, D_MODEL, D_MODEL), D_MODEL ** -0.5),
        'post_mix_g': gain(D_MODEL),
        'pre_ffn_g': gain(D_MODEL),
        'w_up': nrm((DEPTH, D_MODEL, 2 * D_FF), D_MODEL ** -0.5),
        'ffn_conv_w': nrm((DEPTH, FFN_CONV, 2 * D_FF), FFN_CONV ** -0.5),
        'ffn_conv_b': nrm((DEPTH, 2 * D_FF), 0.02),
        'w_down': nrm((DEPTH, D_FF, D_MODEL), D_FF ** -0.5),
        'post_ffn_g': gain(D_MODEL),
    }


def reference(x_prompt, x_sample, cache_mla_ckv, cache_mla_kpe, state_ssd_conv, state_ssd, state_ffn_conv,
              pre_mix_g, w_in, q_norm_g, w_uq, kv_norm_g, w_ukv, ssd_conv_w, ssd_conv_b, ssd_dt_bias,
              ssd_A_log, ssd_D, ssd_norm_g, w_o_mla, w_o_ssd, w_out, post_mix_g, pre_ffn_g, w_up,
              ffn_conv_w, ffn_conv_b, w_down, post_ffn_g):
    bp, S, _ = x_prompt.shape
    bs, Ls, _ = x_sample.shape
    past = cache_mla_ckv.shape[2]
    pos_p = jnp.arange(S, dtype=jnp.int32)
    pos_s = past + jnp.arange(Ls, dtype=jnp.int32)
    hp, hs = x_prompt, x_sample
    ckv_p, kpe_p, sc_p, ss_p, fc_p = [], [], [], [], []
    ckv_s, kpe_s, sc_s, ss_s, fc_s = [], [], [], [], []
    for l in range(DEPTH):
        p = {
            'pre_mix_g': pre_mix_g[l], 'w_in': w_in[l], 'q_norm_g': q_norm_g[l], 'w_uq': w_uq[l],
            'kv_norm_g': kv_norm_g[l], 'w_ukv': w_ukv[l], 'ssd_conv_w': ssd_conv_w[l],
            'ssd_conv_b': ssd_conv_b[l], 'ssd_dt_bias': ssd_dt_bias[l], 'ssd_A_log': ssd_A_log[l],
            'ssd_D': ssd_D[l], 'ssd_norm_g': ssd_norm_g[l], 'w_o_mla': w_o_mla[l], 'w_o_ssd': w_o_ssd[l],
            'w_out': w_out[l], 'post_mix_g': post_mix_g[l], 'pre_ffn_g': pre_ffn_g[l], 'w_up': w_up[l],
            'ffn_conv_w': ffn_conv_w[l], 'ffn_conv_b': ffn_conv_b[l], 'w_down': w_down[l],
            'post_ffn_g': post_ffn_g[l],
        }
        hp, a, b_, c, d, e = encoder_layer(
            hp, pos_p, None, None,
            jnp.zeros((bp, SSD_CONV - 1, CONV_DIM), hp.dtype),
            jnp.zeros((bp, SSD_HEADS, SSD_HEADDIM, SSD_STATE), jnp.float32),
            jnp.zeros((bp, FFN_CONV - 1, 2 * D_FF), hp.dtype), p)
        ckv_p.append(a); kpe_p.append(b_); sc_p.append(c); ss_p.append(d); fc_p.append(e)
        hs, a, b_, c, d, e = encoder_layer(
            hs, pos_s, cache_mla_ckv[l], cache_mla_kpe[l], state_ssd_conv[l], state_ssd[l],
            state_ffn_conv[l], p)
        ckv_s.append(a); kpe_s.append(b_); sc_s.append(c); ss_s.append(d); fc_s.append(e)
    return (hp, hs,
            jnp.stack(ckv_p), jnp.stack(kpe_p), jnp.stack(sc_p), jnp.stack(ss_p), jnp.stack(fc_p),
            jnp.stack(ckv_s), jnp.stack(kpe_s), jnp.stack(sc_s), jnp.stack(ss_s), jnp.stack(fc_s))
```

```cpp
#include <hip/hip_runtime.h>
#include <hip/hip_cooperative_groups.h>
#include <cstdio>
#include <cstdint>
namespace cg = cooperative_groups;

constexpr int DM = 2048, SEQP = 8192, NBP = 4, NBS = 8, LSAMP = 64, PAST = 2048;
constexpr int MP = NBP * SEQP;
constexpr int MS = NBS * LSAMP;
constexpr int MT = MP + MS;
constexpr int KVS = PAST + LSAMP;
constexpr int KVR = MP + NBS * KVS;
constexpr int QLORA = 512, KVLORA = 512, ROPE = 64, NOPE = 128, VHD = 128, NH = 16;
constexpr int SSD_IN = 4096, SSD_H = 64, SSD_P = 64, SSD_G = 8, SSD_N = 128, CONVD = 6144;
constexpr int DFF = 5632;
constexpr int OFF_Q = 0, OFF_KV = 512, OFF_Z = 1088, OFF_XBC = 5184, OFF_DT = 11328, OFF_GATE = 11392, IN_DIM = 15488;
constexpr int S1N = 1280;
constexpr int S2N = 10240;
constexpr int S3N = 4096;
constexpr int WIN_ROWS = S1N + S2N + S3N;
constexpr float EPS = 1e-6f;
constexpr float QSCALE = 0.07216878364870322f * 1.4426950408889634f;

constexpr size_t O_Y = 0;
constexpr size_t O_CKV_P = (size_t)MT * DM;
constexpr size_t O_KPE_P = O_CKV_P + (size_t)MP * 512;
constexpr size_t O_SCONV_P = O_KPE_P + (size_t)MP * 64;
constexpr size_t O_SSD_P = O_SCONV_P + (size_t)NBP * 3 * CONVD;
constexpr size_t O_FCONV_P = O_SSD_P + (size_t)NBP * 64 * 64 * 128;
constexpr size_t O_CKV_S = O_FCONV_P + (size_t)NBP * 2 * 2 * DFF;
constexpr size_t O_KPE_S = O_CKV_S + (size_t)MS * 512;
constexpr size_t O_SCONV_S = O_KPE_S + (size_t)MS * 64;
constexpr size_t O_SSD_S = O_SCONV_S + (size_t)NBS * 3 * CONVD;
constexpr size_t O_FCONV_S = O_SSD_S + (size_t)NBS * 64 * 64 * 128;
constexpr size_t O_TOTAL = O_FCONV_S + (size_t)NBS * 2 * 2 * DFF;
static_assert(O_TOTAL == 94109696, "d_out size");

constexpr size_t MiB = 1u << 20;
constexpr size_t WS_ROPE = 1 * MiB;
constexpr size_t WS_WUP = 4 * MiB, WS_WDN = 48 * MiB;
constexpr size_t WS_U = 70 * MiB;
constexpr size_t WS_DT = 200 * MiB;
constexpr size_t WS_SSQ = 208 * MiB + 512 * 1024;
constexpr size_t WS_P1 = 220 * MiB;
constexpr size_t WS_KN = 220 * MiB;
constexpr size_t WS_CKVB = 415 * MiB;
constexpr size_t WS_KPEB = 463 * MiB + 512 * 1024;
constexpr size_t WS_QN = 470 * MiB;
constexpr size_t WS_QP = 600 * MiB;
constexpr size_t WS_CQN = 665 * MiB;
constexpr size_t WS_V = 697 * MiB + 512 * 1024;
constexpr size_t WS_XBC = 217 * MiB;
constexpr size_t WS_Z = 607 * MiB;
constexpr size_t WS_G = 217 * MiB;
constexpr size_t WS_MRG = 217 * MiB;
constexpr size_t WS_OSSD = 477 * MiB;
constexpr size_t WS_UPA = 200 * MiB;
constexpr size_t WS_UPB = 557 * MiB + 512 * 1024;
constexpr size_t WS_HALO = 915 * MiB;
constexpr size_t WS_XH = 868 * MiB;
constexpr size_t WS_DN = 557 * MiB + 512 * 1024;
constexpr size_t WS_WIN = 924 * MiB, WS_WUQ = 985 * MiB, WS_WUKV = 988 * MiB, WS_WOMLA = 992 * MiB, WS_WOSSD = 1000 * MiB, WS_WOUT = 1016 * MiB;
constexpr size_t WS_END = 1024 * MiB;
static_assert(WS_WIN + (size_t)WIN_ROWS * 2048 * 2 <= WS_WUQ, "w_in_t");
static_assert(WS_KN + (size_t)KVR * 2048 * 2 <= WS_CKVB && WS_V + (size_t)KVR * 2048 * 2 <= WS_WIN, "kn/v");
static_assert(WS_XBC + (size_t)MT * 6144 * 2 <= WS_Z && WS_Z + (size_t)MT * 4096 * 2 <= WS_WIN, "z/xbc");
static_assert(WS_UPA + (size_t)MT * DFF * 2 <= WS_UPB && WS_UPB + (size_t)MT * DFF * 2 <= WS_HALO, "up");
static_assert(WS_P1 + (size_t)MT * S1N * 4 <= WS_CKVB && WS_CKVB + (size_t)KVR * 1024 <= WS_KPEB && WS_KPEB + (size_t)KVR * 128 <= WS_QN, "mla small");

#define LAS __attribute__((address_space(3)))
#define GAS __attribute__((address_space(1)))
typedef unsigned short bf16;
typedef unsigned u32x4 __attribute__((ext_vector_type(4)));
typedef unsigned u32x2 __attribute__((ext_vector_type(2)));
typedef float f32x4 __attribute__((ext_vector_type(4)));
typedef float f32x2 __attribute__((ext_vector_type(2)));
typedef short bf16x8 __attribute__((ext_vector_type(8)));

typedef __bf16 bf16x2_t __attribute__((ext_vector_type(2)));
__device__ __forceinline__ unsigned pk2(float lo, float hi) { f32x2 v = {lo, hi}; bf16x2_t b = __builtin_convertvector(v, bf16x2_t); return __builtin_bit_cast(unsigned, b); }
__device__ __forceinline__ unsigned f2bf(float f) { return pk2(f, 0.f) & 0xffffu; }
#define LBAR() do { asm volatile("s_waitcnt lgkmcnt(0)" ::: "memory"); __builtin_amdgcn_s_barrier(); asm volatile("" ::: "memory"); } while (0)
__device__ __forceinline__ float bflo(unsigned w) { return __builtin_bit_cast(float, w << 16); }
__device__ __forceinline__ float bfhi(unsigned w) { return __builtin_bit_cast(float, w & 0xffff0000u); }
__device__ __forceinline__ float bf1(bf16 v) { return __builtin_bit_cast(float, (unsigned)v << 16); }
__device__ __forceinline__ float wave_sum(float v) {
#pragma unroll
    for (int o = 1; o < 64; o <<= 1) v += __shfl_xor(v, o);
    return v;
}
__device__ __forceinline__ float sigmoidf_(float x) { return __builtin_amdgcn_rcpf(1.0f + __expf(-x)); }
__device__ __forceinline__ float siluf_(float x) { return x * __builtin_amdgcn_rcpf(1.0f + __expf(-x)); }
__device__ __forceinline__ int pos_index(int r) { return r < MP ? (r & (SEQP - 1)) : SEQP + ((r - MP) & 63); }
__device__ __forceinline__ int kv_row(int r) { return r < MP ? r : MP + ((r - MP) >> 6) * KVS + PAST + ((r - MP) & 63); }

namespace pg8 {
#define PG8_LAS __attribute__((address_space(3)))
typedef unsigned short bf16_t;
typedef short bf16x8 __attribute__((ext_vector_type(8)));
typedef float f32x4 __attribute__((ext_vector_type(4)));
typedef unsigned u32x4 __attribute__((ext_vector_type(4)));
constexpr int BM = 256, BK = 64, HALF = 128, HTB = HALF * BK * 2  , STAGE_BYTES = 8 * HTB, NXCD = 8, WGM = 8;

__host__ __device__ __forceinline__ int lds_byte(int r, int c) { const int st = (r >> 4) * 2 + (c >> 5), rr = r & 15, cc = c & 31, ob = rr * 64 + cc * 2; return st * 1024 + (ob ^ (((ob >> 9) & 1) << 5)); }
__host__ __device__ __forceinline__ void stage_rc(int b, int& R, int& C) { const int st = b / 1024, sb = b % 1024, swz = sb ^ (((sb >> 9) & 1) << 5); R = (st >> 1) * 16 + swz / 64; C = (st & 1) * 32 + (swz % 64) / 2; }
__host__ __device__ __forceinline__ int perm32(int rho) { const int n = rho >> 4, i = rho & 15; return 8 * (i >> 2) + 4 * n + (i & 3); }

struct Unit { int pm, pn; };
struct Gemm { const bf16_t* A; const bf16_t* Bt; int M, N, K; int pitch = 0, pn_mod = 0, kslice = 0; };

struct StaticOrder {
    int nM, nN, nwg, G, c;
    __host__ __device__ void init(int M, int N, int G_, int c_) { nM = M / BM; nN = N / BM; nwg = nM * nN; G = G_; c = c_; }
    __host__ __device__ bool next(int i, Unit& u) const {
        const long L = (long)i * G + c; if (L >= nwg) return false;
        int wgid = (int)L; { const int q = nwg / NXCD, r = nwg % NXCD, xcd = wgid % NXCD, off = wgid / NXCD; wgid = (xcd < r ? xcd * (q + 1) : r * (q + 1) + (xcd - r) * q) + off; }
        const int nig = WGM * nN, gid = wgid / nig, fm = gid * WGM, gsz = (nM - fm) < WGM ? (nM - fm) : WGM;
        u.pm = fm + ((wgid % nig) % gsz); u.pn = (wgid % nig) / gsz; return true;
    }
    __device__ __forceinline__ void a_ready(const Unit&) const {}
    __device__ __forceinline__ void done(const Unit&) const {}
};

__device__ __forceinline__ unsigned cvt_pk_bf16(float lo, float hi) { return pk2(lo, hi); }
__device__ __forceinline__ u32x4 pack8(f32x4 v0, f32x4 v1) { u32x4 w; w.x = cvt_pk_bf16(v0[0], v0[1]); w.y = cvt_pk_bf16(v0[2], v0[3]); w.z = cvt_pk_bf16(v1[0], v1[1]); w.w = cvt_pk_bf16(v1[2], v1[3]); return w; }

struct EpiF32 {
    static constexpr bool PERM = false, AFTER_DRAIN = false;
    float* O; int ldc;
    __device__ __forceinline__ void operator()(const f32x4 (&acc)[2][2][4][2], const Unit& u, int wr, int wc, int fr, int fq) const {
        const int row0 = u.pm * BM + wr * 64 + fr, col0 = u.pn * BM + wc * 32 + 4 * fq;
#pragma unroll
        for (int ai = 0; ai < 2; ++ai)
#pragma unroll
            for (int m = 0; m < 4; ++m) { float* rowp = O + (size_t)(row0 + ai * HALF + m * 16) * ldc + col0;
#pragma unroll
                for (int bj = 0; bj < 2; ++bj)
#pragma unroll
                    for (int n = 0; n < 2; ++n) *(f32x4*)(rowp + bj * HALF + n * 16) = acc[ai][bj][m][n]; }
    }
};

template <int ACT, int HALO> struct EpiBf16S {
    static constexpr bool PERM = true, AFTER_DRAIN = false;
    bf16_t* O0; int ld0; int pn_split; bf16_t* O1; int ld1; bf16_t* halo; int ldh; float scale; int nt = 0;
    __device__ __forceinline__ void operator()(const f32x4 (&acc)[2][2][4][2], const Unit& u, int wr, int wc, int fr, int fq) const {
        const int row0 = u.pm * BM + wr * 64 + fr;
        bf16_t* base; int ld, colt;
        if (u.pn < pn_split) { base = O0; ld = ld0; colt = u.pn * BM; } else { base = O1; ld = ld1; colt = (u.pn - pn_split) * BM; }
        const int col0 = colt + wc * 32 + 8 * fq, gcol0 = u.pn * BM + wc * 32 + 8 * fq;
#pragma unroll
        for (int ai = 0; ai < 2; ++ai)
#pragma unroll
            for (int m = 0; m < 4; ++m) { const int row = row0 + ai * HALF + m * 16; bf16_t* rowp = base + (size_t)row * ld + col0;
#pragma unroll
                for (int bj = 0; bj < 2; ++bj) { f32x4 v0 = acc[ai][bj][m][0], v1 = acc[ai][bj][m][1];
                    if (ACT == 1) {
#pragma unroll
                        for (int e = 0; e < 4; ++e) { v0[e] = sigmoidf_(v0[e]); v1[e] = sigmoidf_(v1[e]); } }
                    v0 = v0 * scale; v1 = v1 * scale;
                    const u32x4 w = pack8(v0, v1);
                    if (nt) __builtin_nontemporal_store(w, (u32x4*)(rowp + bj * HALF)); else *(u32x4*)(rowp + bj * HALF) = w;
                    if (HALO > 0) { if (m == 3 && fr >= 16 - HALO) *(u32x4*)(halo + ((size_t)(row >> 6) * HALO + (fr - (16 - HALO))) * ldh + gcol0 + bj * HALF) = w; }
                } }
    }
};

struct EpiQ {
    static constexpr bool PERM = true, AFTER_DRAIN = false;
    bf16_t* QN; bf16_t* QPp; const float* tab;
    __device__ __forceinline__ void operator()(const f32x4 (&acc)[2][2][4][2], const Unit& u, int wr, int wc, int fr, int fq) const {
        const int row0 = u.pm * BM + wr * 64 + fr;
        if (u.pn < 8) {
            const int col0 = u.pn * BM + wc * 32 + 8 * fq;
#pragma unroll
            for (int ai = 0; ai < 2; ++ai)
#pragma unroll
                for (int m = 0; m < 4; ++m) { bf16_t* rowp = QN + (size_t)(row0 + ai * HALF + m * 16) * 2048 + col0;
#pragma unroll
                    for (int bj = 0; bj < 2; ++bj) *(u32x4*)(rowp + bj * HALF) = pack8(acc[ai][bj][m][0] * QSCALE, acc[ai][bj][m][1] * QSCALE); }
        } else {
            const int t = u.pn - 8, s = 4 * (wc & 1) + fq;
#pragma unroll
            for (int ai = 0; ai < 2; ++ai)
#pragma unroll
                for (int m = 0; m < 4; ++m) { const int row = row0 + ai * HALF + m * 16; const float* tp = tab + (size_t)pos_index(row) * 64 + 4 * s;
                    const f32x4 cs = *(const f32x4*)tp, sn = *(const f32x4*)(tp + 32);
#pragma unroll
                    for (int bj = 0; bj < 2; ++bj) { const int head = 4 * t + 2 * bj + (wc >> 1);
                        const f32x4 x1 = acc[ai][bj][m][0], x2 = acc[ai][bj][m][1];
                        const f32x4 o1 = (x1 * cs - x2 * sn) * QSCALE, o2 = (x1 * sn + x2 * cs) * QSCALE;
                        bf16_t* qp = QPp + (size_t)row * 1024 + head * 64 + 4 * s;
                        u32x2 w1, w2; w1.x = cvt_pk_bf16(o1[0], o1[1]); w1.y = cvt_pk_bf16(o1[2], o1[3]); w2.x = cvt_pk_bf16(o2[0], o2[1]); w2.y = cvt_pk_bf16(o2[2], o2[3]);
                        *(u32x2*)qp = w1; *(u32x2*)(qp + 32) = w2; } }
        }
    }
};

struct EpiMerge {
    static constexpr bool PERM = true, AFTER_DRAIN = false;
    bf16_t* O; const bf16_t* G; const bf16_t* OM;
    __device__ __forceinline__ void operator()(const f32x4 (&acc)[2][2][4][2], const Unit& u, int wr, int wc, int fr, int fq) const {
        const int row0 = u.pm * BM + wr * 64 + fr, col0 = u.pn * BM + wc * 32 + 8 * fq;
#pragma unroll
        for (int ai = 0; ai < 2; ++ai)
#pragma unroll
            for (int m = 0; m < 4; ++m) { const size_t row = (size_t)(row0 + ai * HALF + m * 16);
#pragma unroll
                for (int bj = 0; bj < 2; ++bj) { const int c = col0 + bj * HALF;
                    const u32x4 ga = *(const u32x4*)(G + row * 4096 + c), gb = *(const u32x4*)(G + row * 4096 + 2048 + c), om = *(const u32x4*)(OM + row * 2048 + c);
                    const f32x4 a0 = acc[ai][bj][m][0], a1 = acc[ai][bj][m][1];
                    u32x4 w;
                    w.x = cvt_pk_bf16(bflo(ga.x) * bflo(om.x) + bflo(gb.x) * a0[0], bfhi(ga.x) * bfhi(om.x) + bfhi(gb.x) * a0[1]);
                    w.y = cvt_pk_bf16(bflo(ga.y) * bflo(om.y) + bflo(gb.y) * a0[2], bfhi(ga.y) * bfhi(om.y) + bfhi(gb.y) * a0[3]);
                    w.z = cvt_pk_bf16(bflo(ga.z) * bflo(om.z) + bflo(gb.z) * a1[0], bfhi(ga.z) * bfhi(om.z) + bfhi(gb.z) * a1[1]);
                    w.w = cvt_pk_bf16(bflo(ga.w) * bflo(om.w) + bflo(gb.w) * a1[2], bfhi(ga.w) * bfhi(om.w) + bfhi(gb.w) * a1[3]);
                    *(u32x4*)(O + row * 2048 + c) = w; } }
    }
};


struct EpiGateMerge {
    static constexpr bool PERM = true, AFTER_DRAIN = false;
    bf16_t* O; const bf16_t* OM; const bf16_t* OS;
    __device__ __forceinline__ void operator()(const f32x4 (&acc)[2][2][4][2], const Unit& u, int wr, int wc, int fr, int fq) const {
        const int row0 = u.pm * BM + wr * 64 + fr, c = u.pn * HALF + wc * 32 + 8 * fq;
#pragma unroll
        for (int ai = 0; ai < 2; ++ai)
#pragma unroll
            for (int m = 0; m < 4; ++m) { const size_t row = (size_t)(row0 + ai * HALF + m * 16);
                const u32x4 om = *(const u32x4*)(OM + row * 2048 + c), os = *(const u32x4*)(OS + row * 2048 + c);
                const f32x4 a0 = acc[ai][0][m][0], a1 = acc[ai][0][m][1], b0 = acc[ai][1][m][0], b1 = acc[ai][1][m][1];
                u32x4 w;
                w.x = pk2(sigmoidf_(a0[0]) * bflo(om.x) + sigmoidf_(b0[0]) * bflo(os.x), sigmoidf_(a0[1]) * bfhi(om.x) + sigmoidf_(b0[1]) * bfhi(os.x));
                w.y = pk2(sigmoidf_(a0[2]) * bflo(om.y) + sigmoidf_(b0[2]) * bflo(os.y), sigmoidf_(a0[3]) * bfhi(om.y) + sigmoidf_(b0[3]) * bfhi(os.y));
                w.z = pk2(sigmoidf_(a1[0]) * bflo(om.z) + sigmoidf_(b1[0]) * bflo(os.z), sigmoidf_(a1[1]) * bfhi(om.z) + sigmoidf_(b1[1]) * bfhi(os.z));
                w.w = pk2(sigmoidf_(a1[2]) * bflo(om.w) + sigmoidf_(b1[2]) * bflo(os.w), sigmoidf_(a1[3]) * bfhi(om.w) + sigmoidf_(b1[3]) * bfhi(os.w));
                *(u32x4*)(O + row * 2048 + c) = w; }
    }
};
template <class Epi, class Sched, bool ALIGN_EPI = false, bool SP2 = false>
__device__ __forceinline__ void gemm_phase(PG8_LAS unsigned char* lds, const Gemm g, const Sched& S, const Epi& E) {
    const int tid = threadIdx.x, wid = __builtin_amdgcn_readfirstlane(tid >> 6), lane = tid & 63, wr = wid >> 2, wc = wid & 3, fr = lane & 15, fq = lane >> 4;
    const int nt = g.K / BK; const int K = g.pitch ? g.pitch : g.K;
    unsigned voffA[2], voffB[2];
#pragma unroll
    for (int i = 0; i < 2; ++i) { int R, C; stage_rc(tid * 16 + i * 8192, R, C); const int Rb = Epi::PERM ? ((R & ~31) + perm32(R & 31)) : R;
        voffA[i] = (unsigned)(R * K + C) * 2u; voffB[i] = (unsigned)(Rb * K + C) * 2u; }
    const size_t kstep = (size_t)(BK * 2);
    const size_t hstep = (size_t)HALF * K * 2;
    const size_t tstep = 2 * hstep;
    const unsigned ldsw = (unsigned)wid * 1024u;
    const int aoff = lds_byte(wr * 64 + fr, fq * 8), boff = lds_byte(wc * 32 + fr, fq * 8);
#define PG8_SA(b, h) (((b) * 2 + (h)) * HTB)
#define PG8_SB(b, h) ((4 + (b) * 2 + (h)) * HTB)
#define PG8_STAGE(bufoff, gbase, voff) do { _Pragma("unroll") for (int _i = 0; _i < 2; ++_i) \
        __builtin_amdgcn_global_load_lds((const unsigned*)((const char*)(gbase) + (voff)[_i]), (PG8_LAS unsigned*)(lds + (bufoff) + ldsw + _i * 8192), 16, 0, 0); } while (0)
#define PG8_LDA(dst, b, h) do { _Pragma("unroll") for (int m = 0; m < 4; ++m) _Pragma("unroll") for (int k = 0; k < 2; ++k) dst[m][k] = *(const PG8_LAS bf16x8*)(lds + PG8_SA(b, h) + aoff + m * 2048 + k * 1024); } while (0)
#define PG8_LDB(dst, b, h) do { _Pragma("unroll") for (int n = 0; n < 2; ++n) _Pragma("unroll") for (int k = 0; k < 2; ++k) dst[n][k] = *(const PG8_LAS bf16x8*)(lds + PG8_SB(b, h) + boff + n * 2048 + k * 1024); } while (0)
#define PG8_MMA(ai, bj, At, Bt) do { __builtin_amdgcn_s_setprio(1); _Pragma("unroll") for (int m = 0; m < 4; ++m) _Pragma("unroll") for (int n = 0; n < 2; ++n) _Pragma("unroll") for (int k = 0; k < 2; ++k) \
        acc[ai][bj][m][n] = __builtin_amdgcn_mfma_f32_16x16x32_bf16(Bt[n][k], At[m][k], acc[ai][bj][m][n], 0, 0, 0); __builtin_amdgcn_s_setprio(0); } while (0)
#define PG8_WAIT_V(n) asm volatile("s_waitcnt vmcnt(" #n ")" ::: "memory")
#define PG8_WAIT_L(n) asm volatile("s_waitcnt lgkmcnt(" #n ")" ::: "memory")
#define PG8_BAR __builtin_amdgcn_s_barrier()
#define PG8_SCHED __builtin_amdgcn_sched_barrier(0)
    Unit cur, nxt; int ui = 0;
    if (!S.next(0, cur)) return;
    f32x4 acc[2][2][4][2];
#pragma unroll
    for (int a = 0; a < 2; ++a)
#pragma unroll
        for (int b = 0; b < 2; ++b)
#pragma unroll
            for (int m = 0; m < 4; ++m)
#pragma unroll
                for (int n = 0; n < 2; ++n) acc[a][b][m][n] = (f32x4){0.f, 0.f, 0.f, 0.f};
    bf16x8 At[4][2], B0[2][2], B1[2][2];
#define PG8_UA(u_) ((const char*)g.A + (size_t)(u_).pm * tstep + (g.pn_mod ? (size_t)((u_).pn / g.pn_mod) * g.kslice * 2 : (size_t)0))
#define PG8_UB(u_) ((const char*)g.Bt + (g.pn_mod ? (size_t)((u_).pn % g.pn_mod) * tstep + (size_t)((u_).pn / g.pn_mod) * g.kslice * 2 : (size_t)(u_).pn * tstep))
    const char* cA = PG8_UA(cur); const char* cB = PG8_UB(cur);
    S.a_ready(cur);
    if constexpr (SP2) {
        PG8_STAGE(PG8_SB(0, 0), cB, voffB); PG8_STAGE(PG8_SB(0, 1), cB + hstep, voffB); PG8_STAGE(PG8_SA(0, 0), cA, voffA); PG8_STAGE(PG8_SA(0, 1), cA + hstep, voffA);
        if (wr == 1) PG8_BAR;
        PG8_WAIT_V(2); PG8_BAR;
        PG8_STAGE(PG8_SB(1, 0), cB + kstep, voffB); PG8_STAGE(PG8_SA(1, 0), cA + kstep, voffA); PG8_STAGE(PG8_SB(1, 1), cB + hstep + kstep, voffB);
        PG8_WAIT_V(6); PG8_BAR;
    } else {
        PG8_STAGE(PG8_SB(0, 0), cB, voffB); PG8_STAGE(PG8_SA(0, 0), cA, voffA); PG8_STAGE(PG8_SB(0, 1), cB + hstep, voffB); PG8_STAGE(PG8_SA(0, 1), cA + hstep, voffA);
        if (wr == 1) PG8_BAR;
        PG8_WAIT_V(4); PG8_BAR;
        PG8_STAGE(PG8_SB(1, 0), cB + kstep, voffB); PG8_STAGE(PG8_SA(1, 0), cA + kstep, voffA); PG8_STAGE(PG8_SB(1, 1), cB + hstep + kstep, voffB);
        PG8_WAIT_V(6); PG8_BAR;
    }
    for (;;) {
        const bool has_next = S.next(ui + 1, nxt);
        const char* nA = has_next ? PG8_UA(nxt) : cA; const char* nB = has_next ? PG8_UB(nxt) : cB;
        for (int t = 0; t < nt; t += 2) {
            const bool last = (t == nt - 2);
            const char* a1 = cA + (size_t)(t + 1) * kstep;
            const char* a2 = last ? nA : cA + (size_t)(t + 2) * kstep; const char* b2 = last ? nB : cB + (size_t)(t + 2) * kstep;
            const char* a3 = a2 + kstep; const char* b3 = b2 + kstep;
            if (last && has_next) S.a_ready(nxt);
            if constexpr (SP2) {
            PG8_LDB(B0, 0, 0); PG8_LDB(B1, 0, 1); PG8_SCHED; PG8_LDA(At, 0, 0); PG8_STAGE(PG8_SA(1, 1), a1 + hstep, voffA);
            PG8_WAIT_V(8); PG8_WAIT_L(0); PG8_BAR; PG8_MMA(0, 0, At, B0); PG8_MMA(0, 1, At, B1); PG8_BAR; PG8_SCHED;
            PG8_LDA(At, 0, 1); PG8_STAGE(PG8_SB(0, 0), b2, voffB); PG8_STAGE(PG8_SB(0, 1), b2 + hstep, voffB); PG8_STAGE(PG8_SA(0, 0), a2, voffA);
            PG8_WAIT_V(8); PG8_WAIT_L(0); PG8_BAR; PG8_MMA(1, 0, At, B0); PG8_MMA(1, 1, At, B1); PG8_BAR; PG8_SCHED;
            PG8_LDB(B0, 1, 0); PG8_LDB(B1, 1, 1); PG8_SCHED; PG8_LDA(At, 1, 0); PG8_STAGE(PG8_SA(0, 1), a2 + hstep, voffA);
            PG8_WAIT_V(8); PG8_WAIT_L(0); PG8_BAR; PG8_MMA(0, 0, At, B0); PG8_MMA(0, 1, At, B1); PG8_BAR; PG8_SCHED;
            PG8_LDA(At, 1, 1); PG8_STAGE(PG8_SB(1, 0), b3, voffB); PG8_STAGE(PG8_SB(1, 1), b3 + hstep, voffB); PG8_STAGE(PG8_SA(1, 0), a3, voffA);
            PG8_WAIT_V(8); PG8_WAIT_L(0); PG8_BAR; PG8_MMA(1, 0, At, B0); PG8_MMA(1, 1, At, B1); PG8_BAR; PG8_SCHED;
            } else {
            PG8_LDB(B0, 0, 0); PG8_SCHED; PG8_LDA(At, 0, 0); PG8_STAGE(PG8_SA(1, 1), a1 + hstep, voffA);
            PG8_WAIT_L(8); PG8_BAR; PG8_WAIT_L(0); PG8_MMA(0, 0, At, B0); PG8_BAR; PG8_SCHED;
            PG8_LDB(B1, 0, 1); PG8_STAGE(PG8_SB(0, 0), b2, voffB);
            PG8_BAR; PG8_WAIT_L(0); PG8_MMA(0, 1, At, B1); PG8_BAR;
            PG8_LDA(At, 0, 1); PG8_STAGE(PG8_SA(0, 0), a2, voffA);
            PG8_BAR; PG8_WAIT_L(0); PG8_MMA(1, 0, At, B0); PG8_BAR; PG8_SCHED;
            PG8_STAGE(PG8_SB(0, 1), b2 + hstep, voffB);
            PG8_WAIT_V(6); PG8_BAR; PG8_MMA(1, 1, At, B1); PG8_BAR;
            PG8_LDB(B0, 1, 0); PG8_SCHED; PG8_LDA(At, 1, 0); PG8_STAGE(PG8_SA(0, 1), a2 + hstep, voffA);
            PG8_WAIT_L(8); PG8_BAR; PG8_WAIT_L(0); PG8_MMA(0, 0, At, B0); PG8_BAR; PG8_SCHED;
            PG8_LDB(B1, 1, 1); PG8_STAGE(PG8_SB(1, 0), b3, voffB);
            PG8_BAR; PG8_WAIT_L(0); PG8_MMA(0, 1, At, B1); PG8_BAR;
            PG8_LDA(At, 1, 1); PG8_STAGE(PG8_SA(1, 0), a3, voffA);
            PG8_BAR; PG8_WAIT_L(0); PG8_MMA(1, 0, At, B0); PG8_BAR; PG8_SCHED;
            PG8_STAGE(PG8_SB(1, 1), b3 + hstep, voffB);
            PG8_WAIT_V(6); PG8_BAR; PG8_MMA(1, 1, At, B1); PG8_BAR;
            }
        }
        if constexpr (ALIGN_EPI) { if (wr == 0) PG8_BAR; }
        if constexpr (!Epi::AFTER_DRAIN) { E(acc, cur, wr, wc, fr, fq); S.done(cur); }
        if (!has_next) break;
#pragma unroll
        for (int a = 0; a < 2; ++a)
#pragma unroll
            for (int b = 0; b < 2; ++b)
#pragma unroll
                for (int m = 0; m < 4; ++m)
#pragma unroll
                    for (int n = 0; n < 2; ++n) acc[a][b][m][n] = (f32x4){0.f, 0.f, 0.f, 0.f};
        cur = nxt; cA = nA; cB = nB; ++ui;
        if constexpr (ALIGN_EPI) { if (wr == 1) PG8_BAR; }
    }
    PG8_WAIT_V(0);
    if constexpr (!ALIGN_EPI) { if (wr == 0) PG8_BAR; }
    PG8_BAR;
    if constexpr (Epi::AFTER_DRAIN) { E.fused(acc, cur, wr, wc, fr, fq, lds, wid, lane); S.done(cur); }
#undef PG8_UA
#undef PG8_UB
#undef PG8_SA
#undef PG8_SB
#undef PG8_STAGE
#undef PG8_LDA
#undef PG8_LDB
#undef PG8_MMA
#undef PG8_WAIT_V
#undef PG8_WAIT_L
#undef PG8_BAR
#undef PG8_SCHED
}
}
#define XB_TMO      128
#define XB_XCNT(j)  (256  + 64 * (j))
#define XB_XSUB(j)  (1280 + 64 * (j))
#define XB_XGEN(j)  (2304 + 64 * (j))
#define XB_TOP      3328
#define XB_TOPGEN   3392
#define XCD_BAR_WORDS 3456
#define XB_SPIN_CAP (1u << 18)

__device__ __forceinline__ unsigned xb_ld(unsigned* p)              { return __hip_atomic_load(p, __ATOMIC_RELAXED, __HIP_MEMORY_SCOPE_AGENT); }
__device__ __forceinline__ unsigned xb_add(unsigned* p, unsigned v) { return __hip_atomic_fetch_add(p, v, __ATOMIC_RELAXED, __HIP_MEMORY_SCOPE_AGENT); }
__device__ __forceinline__ unsigned xb_xcc_id() { return (unsigned)__builtin_amdgcn_s_getreg((3 << 11) | 20) & 0xFu; }
#define XB_SPIN(cond, bar) do { unsigned _sp = 0; while (cond) { __builtin_amdgcn_s_sleep(1); \
    if ((++_sp & 255u) == 0u) { if (xb_ld(&(bar)[XB_TMO])) break; if (_sp > XB_SPIN_CAP) { atomicAdd(&(bar)[XB_TMO], 1u); break; } } } } while (0)

struct XcdBarrier {
    unsigned* bar; unsigned x;
    volatile LAS unsigned* st;
};

__device__ __forceinline__ XcdBarrier xcd_barrier_post(unsigned* bar, volatile LAS unsigned* st) {
    XcdBarrier b; b.bar = bar; b.x = xb_xcc_id(); b.st = st;
    if (threadIdx.x == 0) (void)xb_add(&bar[XB_XCNT(b.x)], 1u);
    return b;
}
__device__ __forceinline__ void xcd_barrier_complete(unsigned* bar, unsigned x, unsigned& nloc, unsigned& nx) {
    const unsigned G = gridDim.x * gridDim.y * gridDim.z;
    unsigned sum, cnt, mine, sp = 0u;
    for (;;) {
        sum = 0u; cnt = 0u; mine = 0u;
#pragma unroll
        for (unsigned j = 0; j < 16; ++j) { const unsigned c = xb_ld(&bar[XB_XCNT(j)]); sum += c; cnt += (c > 0u) ? 1u : 0u; mine = (j == x) ? c : mine; }
        if (sum == G) break;
        __builtin_amdgcn_s_sleep(1);
        if ((++sp & 255u) == 0u) { if (xb_ld(&bar[XB_TMO])) break; if (sp > XB_SPIN_CAP) { atomicAdd(&bar[XB_TMO], 1u); break; } }
    }
    nloc = mine > 0u ? mine : 1u; nx = cnt > 0u ? cnt : 1u;
}

__device__ __forceinline__ void xcd_barrier(const XcdBarrier& b) {
    asm volatile("s_waitcnt vmcnt(0)" ::: "memory");
    __syncthreads();
    if (threadIdx.x == 0) {
        unsigned* bar = b.bar;
        __builtin_amdgcn_s_waitcnt(0);
        unsigned nloc = b.st[0], nx = b.st[1];
        if (nloc == 0u) { xcd_barrier_complete(bar, b.x, nloc, nx); b.st[0] = nloc; b.st[1] = nx; }
        const unsigned old = xb_add(&bar[XB_XSUB(b.x)], 1u);
        const unsigned gen = old / nloc;
        if (old + 1u == (gen + 1u) * nloc) {
            __builtin_amdgcn_fence(__ATOMIC_RELEASE, "agent");
            asm volatile("s_waitcnt vmcnt(0)" ::: "memory");
            const unsigned og = xb_add(&bar[XB_TOP], 1u);
            const unsigned tg = og / nx;
            if (og + 1u == (tg + 1u) * nx) xb_add(&bar[XB_TOPGEN], 1u);
            else XB_SPIN(xb_ld(&bar[XB_TOPGEN]) == tg, bar);
            __builtin_amdgcn_fence(__ATOMIC_ACQUIRE, "agent");
            xb_add(&bar[XB_XGEN(b.x)], 1u);
            asm volatile("s_waitcnt vmcnt(0)" ::: "memory");
        } else {
            XB_SPIN(xb_ld(&bar[XB_XGEN(b.x)]) == gen, bar);
            __builtin_amdgcn_fence(__ATOMIC_ACQUIRE, "agent");
            asm volatile("s_waitcnt vmcnt(0)" ::: "memory");
        }
    }
    __syncthreads();
}
constexpr int NWAVES = 8;
constexpr int RING_BYTES = 131072;
constexpr int LDS_BYTES = 163840;

struct Args {
    const float* in[29];
    float* out; unsigned char* ws;
    int ph_lo, ph_hi;
};

struct Frame {
    LAS unsigned char* lds;
    int tid, lane, wave, G;
    const float* const* in;
    float* out; unsigned char* ws;
};

__device__ __forceinline__ int dst_row(int mat, int n) {
    if (mat == 0) {
        if (n < OFF_Z) return n;
        if (n < OFF_XBC) return n - OFF_Z + S1N;
        if (n < OFF_DT) return n - OFF_XBC + S1N + 4096;
        if (n < OFF_GATE) return n - OFF_DT + 1088;
        const int g = n - OFF_GATE, c = g & 2047;
        return S1N + S2N + 256 * (c >> 7) + ((g >> 11) << 7) + (c & 127);
    }
    if (mat == 1) {
        const int h = n / 192, d = n - h * 192;
        if (d < 128) return h * 128 + d;
        const int i = d - 128, t = h >> 2, hh = h & 3;
        const int s = (i & 31) >> 2, e = (i & 3) + ((i >> 5) << 2);
        return 2048 + t * 256 + 8 * (hh * 8 + s) + e;
    }
    if (mat == 2) {
        const int h = n >> 8, d = n & 255;
        return d < 128 ? h * 128 + d : 2048 + h * 128 + (d - 128);
    }
    return n;
}
__device__ __forceinline__ void p0_transpose_item(const float* W, int K, int N, bf16* WT, int mat, const float* kscale, LAS float* scr, int item, int lane) {
    const int nblk = N / 32, kb = item / nblk, nb = item % nblk, k0 = 64 * kb, n0 = 32 * nb;
#pragma unroll 8
    for (int i = 0; i < 32; ++i) { const int kk = 2 * i + (lane >> 5); float v = __builtin_nontemporal_load(W + (size_t)(k0 + kk) * N + n0 + (lane & 31)); if (kscale) v *= kscale[k0 + kk]; scr[kk * 33 + (lane & 31)] = v; }
    asm volatile("s_waitcnt lgkmcnt(0)" ::: "memory");
    const int c = lane & 7;
#pragma unroll
    for (int j = 0; j < 4; ++j) { const int n = (lane >> 3) + 8 * j; const LAS float* s = scr + (8 * c) * 33 + n;
        u32x4 o; o.x = pk2(s[0 * 33], s[1 * 33]); o.y = pk2(s[2 * 33], s[3 * 33]); o.z = pk2(s[4 * 33], s[5 * 33]); o.w = pk2(s[6 * 33], s[7 * 33]);
        *(u32x4*)(WT + (size_t)dst_row(mat, n0 + n) * K + k0 + 8 * c) = o; }
    asm volatile("s_waitcnt lgkmcnt(0)" ::: "memory");
}
__device__ __forceinline__ void rms_row_bf16(const float* xrow, const float* g, bf16* orow, int lane) {
    const f32x4* xr = (const f32x4*)xrow + lane; const f32x4* gr = (const f32x4*)g + lane;
    f32x4 v[8]; float s = 0.f;
#pragma unroll
    for (int j = 0; j < 8; ++j) { v[j] = __builtin_nontemporal_load(xr + 64 * j); s += (v[j].x * v[j].x + v[j].y * v[j].y) + (v[j].z * v[j].z + v[j].w * v[j].w); }
    const float rstd = 1.0f / sqrtf(wave_sum(s) * (1.f / DM) + EPS);
    u32x2* o8 = (u32x2*)orow + lane;
#pragma unroll
    for (int j = 0; j < 8; ++j) { const f32x4 gg = gr[64 * j]; u32x2 w; w.x = pk2(v[j].x * rstd * gg.x, v[j].y * rstd * gg.y); w.y = pk2(v[j].z * rstd * gg.z, v[j].w * rstd * gg.w); o8[64 * j] = w; }
}
__device__ __forceinline__ const float* x_row(const Frame& F, int r) { return r < MP ? F.in[0] + (size_t)r * DM : F.in[1] + (size_t)(r - MP) * DM; }

__device__ __forceinline__ void p0_prologue(Frame& F) {
    LAS float* scr = (LAS float*)(F.lds + F.wave * 16384);
    const int gw = blockIdx.x * NWAVES + F.wave, NGW = F.G * NWAVES;
    constexpr int I0 = 32 * (IN_DIM / 32), I1 = 8 * 96, I2 = 8 * 128, I3 = 32 * 64, I4 = 64 * 64, I5 = 32 * 64, I6 = 32 * 352, I7 = 88 * 64;
    constexpr int NITEMS = I0 + I1 + I2 + I3 + I4 + I5 + I6 + I7;
    unsigned char* ws = F.ws;
    for (int it = gw; it < NITEMS; it += NGW) {
        int r = it;
        if (r < I0) { p0_transpose_item(F.in[8], 2048, IN_DIM, (bf16*)(ws + WS_WIN), 0, nullptr, scr, r, F.lane); continue; } r -= I0;
        if (r < I1) { p0_transpose_item(F.in[10], 512, 3072, (bf16*)(ws + WS_WUQ), 1, nullptr, scr, r, F.lane); continue; } r -= I1;
        if (r < I2) { p0_transpose_item(F.in[12], 512, 4096, (bf16*)(ws + WS_WUKV), 2, nullptr, scr, r, F.lane); continue; } r -= I2;
        if (r < I3) { p0_transpose_item(F.in[19], 2048, 2048, (bf16*)(ws + WS_WOMLA), 3, nullptr, scr, r, F.lane); continue; } r -= I3;
        if (r < I4) { p0_transpose_item(F.in[20], 4096, 2048, (bf16*)(ws + WS_WOSSD), 3, F.in[18], scr, r, F.lane); continue; } r -= I4;
        if (r < I5) { p0_transpose_item(F.in[21], 2048, 2048, (bf16*)(ws + WS_WOUT), 3, nullptr, scr, r, F.lane); continue; } r -= I5;
        if (r < I6) { p0_transpose_item(F.in[24], 2048, 2 * DFF, (bf16*)(ws + WS_WUP), 3, nullptr, scr, r, F.lane); continue; } r -= I6;
        p0_transpose_item(F.in[27], DFF, 2048, (bf16*)(ws + WS_WDN), 3, nullptr, scr, r, F.lane);
    }
    for (int m = gw; m < MT; m += NGW) rms_row_bf16(x_row(F, m), F.in[7], (bf16*)(ws + WS_U) + (size_t)m * DM, F.lane);
    { float* tab = (float*)(ws + WS_ROPE); const int gt = blockIdx.x * 512 + F.tid, NT = F.G * 512;
        for (int e = gt; e < (SEQP + LSAMP) * 32; e += NT) { const int pi = e >> 5, i = e & 31; const int pos = pi < SEQP ? pi : PAST + (pi - SEQP);
            const float inv = powf(10000.0f, -(float)i * (1.0f / 32.0f)); const float a = (float)pos * inv;
            tab[pi * 64 + i] = cosf(a); tab[pi * 64 + 32 + i] = sinf(a); } }
    { const int gt = blockIdx.x * 512 + F.tid, NT = F.G * 512;
        bf16* ckvb = (bf16*)(ws + WS_CKVB); bf16* kpeb = (bf16*)(ws + WS_KPEB);
        for (int e = gt; e < NBS * PAST * 128; e += NT) { const int row = e >> 7, c4 = e & 127; const int b = row / PAST, t = row - b * PAST;
            const f32x4 v = __builtin_nontemporal_load((const f32x4*)F.in[2] + (size_t)row * 128 + c4); u32x2 w; w.x = pk2(v.x, v.y); w.y = pk2(v.z, v.w);
            *((u32x2*)(ckvb + (size_t)(MP + b * KVS + t) * 512) + c4) = w; }
        for (int e = gt; e < NBS * PAST * 16; e += NT) { const int row = e >> 4, c4 = e & 15; const int b = row / PAST, t = row - b * PAST;
            const f32x4 v = *((const f32x4*)F.in[3] + (size_t)row * 16 + c4); u32x2 w; w.x = pk2(v.x, v.y); w.y = pk2(v.z, v.w);
            *((u32x2*)(kpeb + (size_t)(MP + b * KVS + t) * 64) + c4) = w; } }
}

__device__ __forceinline__ void p0b_ffn_weights(Frame& F, int wg, int nwg) {
    LAS float* scr = (LAS float*)(F.lds + F.wave * 16384);
    constexpr int I6 = 32 * 352, I7 = 88 * 64;
    for (int it = wg * NWAVES + F.wave; it < I6 + I7; it += nwg * NWAVES) {
        if (it < I6) p0_transpose_item(F.in[24], 2048, 2 * DFF, (bf16*)(F.ws + WS_WUP), 3, nullptr, scr, it, F.lane);
        else p0_transpose_item(F.in[27], DFF, 2048, (bf16*)(F.ws + WS_WDN), 3, nullptr, scr, it - I6, F.lane);
    }
}

__device__ __forceinline__ void p2_mla_prep(Frame& F) {
    const int gw = blockIdx.x * NWAVES + F.wave, NGW = F.G * NWAVES, lane = F.lane;
    unsigned char* ws = F.ws;
    const float* P1 = (const float*)(ws + WS_P1); const float* tab = (const float*)(ws + WS_ROPE);
    const f32x4* qg = (const f32x4*)F.in[9] + lane; const f32x4* kg = (const f32x4*)F.in[11] + lane;
    for (int r = gw; r < MT; r += NGW) {
        const float* row = P1 + (size_t)r * S1N;
        const f32x4 q0 = __builtin_nontemporal_load((const f32x4*)row + lane), q1 = __builtin_nontemporal_load((const f32x4*)row + 64 + lane);
        const f32x4 k0 = __builtin_nontemporal_load((const f32x4*)(row + 512) + lane), k1 = __builtin_nontemporal_load((const f32x4*)(row + 512) + 64 + lane);
        float sq = (q0.x * q0.x + q0.y * q0.y) + (q0.z * q0.z + q0.w * q0.w) + (q1.x * q1.x + q1.y * q1.y) + (q1.z * q1.z + q1.w * q1.w);
        float sk = (k0.x * k0.x + k0.y * k0.y) + (k0.z * k0.z + k0.w * k0.w) + (k1.x * k1.x + k1.y * k1.y) + (k1.z * k1.z + k1.w * k1.w);
        const float rq = 1.0f / sqrtf(wave_sum(sq) * (1.f / 512.f) + EPS), rk = 1.0f / sqrtf(wave_sum(sk) * (1.f / 512.f) + EPS);
        { const f32x4 g0 = qg[0], g1 = qg[64]; u32x2* o = (u32x2*)((bf16*)(ws + WS_CQN) + (size_t)r * 512) + lane;
            u32x2 w; w.x = pk2(q0.x * rq * g0.x, q0.y * rq * g0.y); w.y = pk2(q0.z * rq * g0.z, q0.w * rq * g0.w); o[0] = w;
            w.x = pk2(q1.x * rq * g1.x, q1.y * rq * g1.y); w.y = pk2(q1.z * rq * g1.z, q1.w * rq * g1.w); o[64] = w; }
        const int kr = kv_row(r);
        { const f32x4 g0 = kg[0], g1 = kg[64];
            const f32x4 c0 = {k0.x * rk * g0.x, k0.y * rk * g0.y, k0.z * rk * g0.z, k0.w * rk * g0.w}, c1 = {k1.x * rk * g1.x, k1.y * rk * g1.y, k1.z * rk * g1.z, k1.w * rk * g1.w};
            float* oc = r < MP ? F.out + O_CKV_P + (size_t)r * 512 : F.out + O_CKV_S + (size_t)(r - MP) * 512;
            __builtin_nontemporal_store(c0, (f32x4*)oc + lane); __builtin_nontemporal_store(c1, (f32x4*)oc + 64 + lane);
            u32x2* o = (u32x2*)((bf16*)(ws + WS_CKVB) + (size_t)kr * 512) + lane;
            u32x2 w; w.x = pk2(c0.x, c0.y); w.y = pk2(c0.z, c0.w); o[0] = w; w.x = pk2(c1.x, c1.y); w.y = pk2(c1.z, c1.w); o[64] = w; }
        { const int i = lane & 31; const float x1 = row[1024 + i], x2 = row[1056 + i]; const float* tp = tab + (size_t)pos_index(r) * 64;
            const float cs = tp[i], sn = tp[32 + i]; const float o = lane < 32 ? x1 * cs - x2 * sn : x1 * sn + x2 * cs;
            float* ok = r < MP ? F.out + O_KPE_P + (size_t)r * 64 : F.out + O_KPE_S + (size_t)(r - MP) * 64;
            ok[lane] = o; ((bf16*)(ws + WS_KPEB))[(size_t)kr * 64 + lane] = (bf16)f2bf(o); }
        { const float x = row[1088 + lane] + F.in[15][lane]; const float sp = x > 20.f ? x : log1pf(__expf(x)); ((float*)(ws + WS_DT))[(size_t)r * 64 + lane] = sp; }
    }
}

typedef float f32x16 __attribute__((ext_vector_type(16)));
typedef short v4i16_t __attribute__((ext_vector_type(4)));
constexpr int AT_KN = 0, AT_V = 16384, AT_KPE = 32768, AT_STAGE = 40960;
__device__ __forceinline__ void glds16(const void* gsrc, unsigned lds_dst) { unsigned keep;
    asm volatile("s_mov_b32 %0, m0\n\ts_mov_b32 m0, %2\n\ts_nop 0\n\tglobal_load_lds_dwordx4 %1, off\n\ts_mov_b32 m0, %0" : "=&s"(keep) : "v"(gsrc), "s"(lds_dst) : "memory"); }
__device__ __forceinline__ int offb(int row, int ch) { return 256 * row + 16 * (ch ^ (((row & 3) << 2) | ((row >> 2) & 3))); }
__device__ __forceinline__ int offp(int row, int ch) { return 128 * row + 16 * (ch ^ ((row >> 1) & 7)); }

template <int ST> __device__ __forceinline__ void attn_tile(LAS unsigned char* lds, const bf16x8 (&qr)[12], f32x16 (&o)[4], float& mrun, float& lrun,
                                                            int kbase, int xh, int pbase, int x2h, const int (&vlo)[4], int dv) {
    LAS unsigned char* sb = lds + ST * AT_STAGE;
    asm volatile("" : "+v"(dv), "+v"(x2h), "+v"(xh));
    int pa[4], vhi[4], ka[8];
#pragma unroll
    for (int s = 0; s < 8; ++s) ka[s] = kbase + 32 * (s ^ xh);
#pragma unroll
    for (int s = 0; s < 4; ++s) { pa[s] = pbase + 32 * (s ^ x2h); vhi[s] = vlo[s] + dv; }
    f32x16 p0, p1;
#pragma unroll
    for (int r = 0; r < 16; ++r) { p0[r] = 0.f; p1[r] = 0.f; }
#pragma unroll
    for (int s = 0; s < 8; ++s) {
        const bf16x8 a0 = *(const LAS bf16x8*)(sb + AT_KN + ka[s]), a1 = *(const LAS bf16x8*)(sb + AT_KN + 8192 + ka[s]);
        p0 = __builtin_amdgcn_mfma_f32_32x32x16_bf16(a0, qr[s], p0, 0, 0, 0); p1 = __builtin_amdgcn_mfma_f32_32x32x16_bf16(a1, qr[s], p1, 0, 0, 0);
    }
#pragma unroll
    for (int s = 0; s < 4; ++s) {
        const bf16x8 a0 = *(const LAS bf16x8*)(sb + AT_KPE + pa[s]), a1 = *(const LAS bf16x8*)(sb + AT_KPE + 4096 + pa[s]);
        p0 = __builtin_amdgcn_mfma_f32_32x32x16_bf16(a0, qr[8 + s], p0, 0, 0, 0); p1 = __builtin_amdgcn_mfma_f32_32x32x16_bf16(a1, qr[8 + s], p1, 0, 0, 0);
    }
    float mx = p0[0];
#pragma unroll
    for (int r = 1; r < 16; ++r) mx = fmaxf(mx, p0[r]);
#pragma unroll
    for (int r = 0; r < 16; ++r) mx = fmaxf(mx, p1[r]);
    mx = fmaxf(mx, __shfl_xor(mx, 32));
    const float mnew = fmaxf(mrun, mx), alpha = __builtin_amdgcn_exp2f(mrun - mnew);
    mrun = mnew;
    float ps = 0.f;
#pragma unroll
    for (int r = 0; r < 16; ++r) { p0[r] = __builtin_amdgcn_exp2f(p0[r] - mnew); p1[r] = __builtin_amdgcn_exp2f(p1[r] - mnew); ps += p0[r] + p1[r]; }
    lrun = lrun * alpha + ps;
#pragma unroll
    for (int b = 0; b < 4; ++b)
#pragma unroll
        for (int r = 0; r < 16; ++r) o[b][r] *= alpha;
#pragma unroll
    for (int ks = 0; ks < 4; ++ks) {
        u32x4 w;
        if (ks < 2) { w.x = pk2(p0[8 * ks + 0], p0[8 * ks + 1]); w.y = pk2(p0[8 * ks + 2], p0[8 * ks + 3]); w.z = pk2(p0[8 * ks + 4], p0[8 * ks + 5]); w.w = pk2(p0[8 * ks + 6], p0[8 * ks + 7]); }
        else { const int k2 = ks - 2; w.x = pk2(p1[8 * k2 + 0], p1[8 * k2 + 1]); w.y = pk2(p1[8 * k2 + 2], p1[8 * k2 + 3]); w.z = pk2(p1[8 * k2 + 4], p1[8 * k2 + 5]); w.w = pk2(p1[8 * k2 + 6], p1[8 * k2 + 7]); }
        const bf16x8 pf = __builtin_bit_cast(bf16x8, w);
#pragma unroll
        for (int b = 0; b < 4; ++b) {
            const v4i16_t lo = __builtin_amdgcn_ds_read_tr16_b64_v4i16((LAS v4i16_t*)(sb + AT_V + ks * 4096 + vlo[b]));
            const v4i16_t hi = __builtin_amdgcn_ds_read_tr16_b64_v4i16((LAS v4i16_t*)(sb + AT_V + ks * 4096 + vhi[b]));
            const bf16x8 af = {lo[0], lo[1], lo[2], lo[3], hi[0], hi[1], hi[2], hi[3]};
            o[b] = __builtin_amdgcn_mfma_f32_32x32x16_bf16(af, pf, o[b], 0, 0, 0);
        }
    }
}

__device__ __forceinline__ void attn_unit(LAS unsigned char* lds, const bf16* QN, const bf16* QP, const bf16* KN, const bf16* KPE, const bf16* V, bf16* O,
                                          int q_row0, int kv_row0, int h, int NT, int ntw, int tid, int wave, int lane) {
    const int r32 = lane & 31, hh = lane >> 5;
    bf16x8 qr[12];
    if (ntw > 0) {
        const bf16* qn = QN + (size_t)(q_row0 + 32 * wave + r32) * 2048 + h * 128 + 8 * hh;
        const bf16* qp = QP + (size_t)(q_row0 + 32 * wave + r32) * 1024 + h * 64 + 8 * hh;
#pragma unroll
        for (int s = 0; s < 8; ++s) qr[s] = __builtin_nontemporal_load((const bf16x8*)(qn + 16 * s));
#pragma unroll
        for (int s = 0; s < 4; ++s) qr[8 + s] = __builtin_nontemporal_load((const bf16x8*)(qp + 16 * s));
    }
    asm volatile("" : "+v"(qr[0]), "+v"(qr[1]), "+v"(qr[2]), "+v"(qr[3]), "+v"(qr[4]), "+v"(qr[5]), "+v"(qr[6]), "+v"(qr[7]), "+v"(qr[8]), "+v"(qr[9]), "+v"(qr[10]), "+v"(qr[11]));
    const bf16* knsrc = KN + (size_t)kv_row0 * 2048 + h * 128;
    const bf16* vsrc = V + (size_t)kv_row0 * 2048 + h * 128;
    const bf16* kpsrc = KPE + (size_t)kv_row0 * 64;
    const int rowA = wave * 4 + (lane >> 4), chA = (lane & 15) ^ ((((lane >> 4) & 3) << 2) | (wave & 3));
    const int rowP = wave * 8 + (lane >> 3), chP = (lane & 7) ^ ((rowP >> 1) & 7);
    const int koff = rowA * 2048 + chA * 8, poff = rowP * 64 + chP * 8;
    const unsigned ldsw = (unsigned)(uintptr_t)lds + (unsigned)wave * 1024u;
#define AT_DMA(kt, st) do { const bf16* kb_ = knsrc + (size_t)(kt) * 64 * 2048; const bf16* vb_ = vsrc + (size_t)(kt) * 64 * 2048; const bf16* pb_ = kpsrc + (size_t)(kt) * 64 * 64; \
        const unsigned l_ = (unsigned)__builtin_amdgcn_readfirstlane((int)(ldsw + (unsigned)((st) * AT_STAGE))); \
        glds16(kb_ + koff, l_ + AT_KN); glds16(kb_ + koff + 32 * 2048, l_ + AT_KN + 8192); \
        glds16(vb_ + koff, l_ + AT_V); glds16(vb_ + koff + 32 * 2048, l_ + AT_V + 8192); \
        glds16(pb_ + poff, l_ + AT_KPE); } while (0)
    __syncthreads();
    AT_DMA(0, 0);
    if (NT > 1) { AT_DMA(1, 1); asm volatile("s_waitcnt vmcnt(5)" ::: "memory"); } else { asm volatile("s_waitcnt vmcnt(0)" ::: "memory"); }
    __builtin_amdgcn_s_barrier(); asm volatile("" ::: "memory");
    f32x16 o[4];
#pragma unroll
    for (int b = 0; b < 4; ++b)
#pragma unroll
        for (int r = 0; r < 16; ++r) o[b][r] = 0.f;
    float mrun = -1e30f, lrun = 0.f;
    int vlo[4], kbase, xh, pbase, x2h, dv;
    { const int x = ((r32 & 3) << 2) | ((r32 >> 2) & 3), xl = x & 1; xh = x >> 1; kbase = 256 * r32 + 16 * (hh ^ xl);
      const int x2 = (r32 >> 1) & 7, x2l = x2 & 1; x2h = x2 >> 1; pbase = 128 * r32 + 16 * (hh ^ x2l);
      const int g1 = (lane >> 4) & 1, qq = (lane & 15) >> 2, pq = lane & 3, cbase = 2 * g1 + (pq >> 1);
#pragma unroll
      for (int b = 0; b < 4; ++b) vlo[b] = 256 * (4 * hh + qq) + 16 * ((4 * b + cbase) ^ ((qq << 2) | hh)) + 8 * (pq & 1);
      dv = 2048 + 16 * ((cbase ^ (hh + 2)) - (cbase ^ hh)); }
#define AT_STEP(k, ST) do { \
        if ((k) + 2 < NT) AT_DMA((k) + 2, ((ST) + 2) % 3); \
        if ((k) < ntw) attn_tile<ST>(lds, qr, o, mrun, lrun, kbase, xh, pbase, x2h, vlo, dv); \
        if ((k) + 2 < NT) { asm volatile("s_waitcnt vmcnt(5) lgkmcnt(0)" ::: "memory"); } else { asm volatile("s_waitcnt vmcnt(0) lgkmcnt(0)" ::: "memory"); } \
        __builtin_amdgcn_s_barrier(); asm volatile("" ::: "memory"); } while (0)
    for (int kt = 0; kt < NT; kt += 3) {
        AT_STEP(kt, 0);
        if (kt + 1 < NT) AT_STEP(kt + 1, 1);
        if (kt + 2 < NT) AT_STEP(kt + 2, 2);
    }
#undef AT_STEP
#undef AT_DMA
    if (ntw > 0) {
        const float lt = lrun + __shfl_xor(lrun, 32), inv = 1.0f / lt;
        bf16* orow = O + (size_t)(q_row0 + 32 * wave + r32) * 2048 + h * 128;
#pragma unroll
        for (int b = 0; b < 4; ++b)
#pragma unroll
            for (int rq = 0; rq < 4; ++rq) { u32x2 w; w.x = pk2(o[b][4 * rq] * inv, o[b][4 * rq + 1] * inv); w.y = pk2(o[b][4 * rq + 2] * inv, o[b][4 * rq + 3] * inv);
                *(u32x2*)(orow + 32 * b + 8 * rq + 4 * hh) = w; }
    }
}

__device__ __forceinline__ void p4_attention(Frame& F, bf16* Odummy) {
    unsigned char* ws = F.ws;
    const bf16* QN = (const bf16*)(ws + WS_QN); const bf16* QPp = (const bf16*)(ws + WS_QP); const bf16* KN = (const bf16*)(ws + WS_KN);
    const bf16* KPE = (const bf16*)(ws + WS_KPEB); const bf16* V = (const bf16*)(ws + WS_V); bf16* O = Odummy ? Odummy : (bf16*)(ws + WS_QN);
    const int bx = blockIdx.x; const int vcu = (F.G % 8 == 0) ? (bx % 8) * (F.G / 8) + bx / 8 : bx;
    for (int pr = vcu; pr < 1024; pr += F.G) {
        const int bh = pr >> 4, pp = pr & 15, b = bh >> 4, h = bh & 15;
#pragma unroll 1
        for (int i = 0; i < 2; ++i) { const int qb = i ? 31 - pp : pp;
            attn_unit(F.lds, QN, QPp, KN, KPE, V, O, b * SEQP + qb * 256, b * SEQP, h, 4 * (qb + 1), 4 * qb + (F.wave >> 1) + 1, F.tid, F.wave, F.lane); }
    }
    for (int su = vcu; su < NBS * NH; su += F.G) { const int b = su >> 4, h = su & 15;
        attn_unit(F.lds, QN, QPp, KN, KPE, V, O, MP + b * 64, MP + b * KVS, h, KVS / 64, F.wave < 2 ? KVS / 64 : 0, F.tid, F.wave, F.lane); }
}

__device__ __forceinline__ void p6a_conv(Frame& F) {
    const int gw = blockIdx.x * NWAVES + F.wave, NGW = F.G * NWAVES, lane = F.lane;
    bf16* X = (bf16*)(F.ws + WS_XBC); const bf16* XH = (const bf16*)(F.ws + WS_XH);
    const float* cw = F.in[13]; const float* cbv = F.in[14];
    constexpr int NCH = MT / 64, NSL = CONVD / 512;
    for (int u = gw; u < NCH * NSL; u += NGW) {
        const int ch = u / NSL, sl = u - ch * NSL, col = sl * 512 + lane * 8;
        float w[4][8], bs[8];
#pragma unroll
        for (int k = 0; k < 4; ++k) { const f32x4 a0 = *(const f32x4*)(cw + k * CONVD + col), a1 = *(const f32x4*)(cw + k * CONVD + col + 4);
#pragma unroll
            for (int e = 0; e < 4; ++e) { w[k][e] = a0[e]; w[k][4 + e] = a1[e]; } }
        { const f32x4 a0 = *(const f32x4*)(cbv + col), a1 = *(const f32x4*)(cbv + col + 4);
#pragma unroll
            for (int e = 0; e < 4; ++e) { bs[e] = a0[e]; bs[4 + e] = a1[e]; } }
        float h3[8], h2[8], h1[8];
        const bool first = ch < MP / 64 ? ((ch & 127) == 0) : true;
        const bool last = ch < MP / 64 ? ((ch & 127) == 127) : true;
        if (first) {
            if (ch < MP / 64) {
#pragma unroll
                for (int e = 0; e < 8; ++e) { h3[e] = 0.f; h2[e] = 0.f; h1[e] = 0.f; }
            } else { const float* hs = F.in[4] + (size_t)(ch - MP / 64) * 3 * CONVD + col;
#pragma unroll
                for (int e = 0; e < 8; ++e) { h3[e] = hs[e]; h2[e] = hs[CONVD + e]; h1[e] = hs[2 * CONVD + e]; } }
        } else { const bf16* hp = XH + (size_t)(ch - 1) * 3 * CONVD + col;
            const u32x4 x0 = *(const u32x4*)hp, x1 = *(const u32x4*)(hp + CONVD), x2 = *(const u32x4*)(hp + 2 * CONVD);
#pragma unroll
            for (int e = 0; e < 4; ++e) { h3[2 * e] = bflo(x0[e]); h3[2 * e + 1] = bfhi(x0[e]); h2[2 * e] = bflo(x1[e]); h2[2 * e + 1] = bfhi(x1[e]); h1[2 * e] = bflo(x2[e]); h1[2 * e + 1] = bfhi(x2[e]); } }
        float* oc = nullptr;
        if (last) oc = (ch < MP / 64 ? F.out + O_SCONV_P + (size_t)(ch >> 7) * 3 * CONVD : F.out + O_SCONV_S + (size_t)(ch - MP / 64) * 3 * CONVD) + col;
        bf16* xp = X + (size_t)ch * 64 * CONVD + col;
        for (int tb = 0; tb < 64; tb += 8) {
            u32x4 rv[8];
#pragma unroll
            for (int i = 0; i < 8; ++i) rv[i] = __builtin_nontemporal_load((const u32x4*)(xp + (size_t)(tb + i) * CONVD));
#pragma unroll
            for (int i = 0; i < 8; ++i) {
                float c0[8], o[8];
#pragma unroll
                for (int e = 0; e < 4; ++e) { c0[2 * e] = bflo(rv[i][e]); c0[2 * e + 1] = bfhi(rv[i][e]); }
#pragma unroll
                for (int e = 0; e < 8; ++e) { const float s = bs[e] + w[0][e] * h3[e] + w[1][e] * h2[e] + w[2][e] * h1[e] + w[3][e] * c0[e]; o[e] = siluf_(s); h3[e] = h2[e]; h2[e] = h1[e]; h1[e] = c0[e]; }
                u32x4 wv; wv.x = pk2(o[0], o[1]); wv.y = pk2(o[2], o[3]); wv.z = pk2(o[4], o[5]); wv.w = pk2(o[6], o[7]);
                *(u32x4*)(xp + (size_t)(tb + i) * CONVD) = wv;
                if (oc && tb + i >= 61) { float* o2 = oc + (size_t)(tb + i - 61) * CONVD;
#pragma unroll
                    for (int e = 0; e < 8; ++e) o2[e] = c0[e]; }
            }
        }
    }
}

constexpr int SD_BUF = 53248;
constexpr int SDB_XS = 0;
constexpr int SDB_XW = 9216;
constexpr int SDB_BS = 18432;
constexpr int SDB_CS = 35840;
constexpr int SD_MS = 2 * SD_BUF;
constexpr int SD_HS = SD_MS + 9216;
constexpr int SD_SSQ = SD_HS + 2 * 17408;
constexpr int SD_AW = SD_SSQ + 2048;
constexpr int SD_END = SD_AW + 8 * 512;
static_assert(SD_END <= LDS_BYTES, "ssd lds");

__device__ __forceinline__ bf16x8 tr8(const LAS unsigned char* p, int rowstride4) {
    const v4i16_t lo = __builtin_amdgcn_ds_read_tr16_b64_v4i16((LAS v4i16_t*)p), hi = __builtin_amdgcn_ds_read_tr16_b64_v4i16((LAS v4i16_t*)(p + rowstride4));
    return (bf16x8){lo[0], lo[1], lo[2], lo[3], hi[0], hi[1], hi[2], hi[3]};
}
__device__ __forceinline__ f32x4 mm16(const LAS unsigned char* A, int lda, const LAS unsigned char* B, int ldb, int nks, f32x4 acc, int lane) {
    const LAS unsigned char* a = A + (lane & 15) * lda + (lane >> 4) * 16; const LAS unsigned char* b = B + (lane & 15) * ldb + (lane >> 4) * 16;
#pragma unroll
    for (int ks = 0; ks < nks; ++ks) acc = __builtin_amdgcn_mfma_f32_16x16x32_bf16(*(const LAS bf16x8*)(a + ks * 64), *(const LAS bf16x8*)(b + ks * 64), acc, 0, 0, 0);
    return acc;
}
__device__ __forceinline__ f32x4 mm16_ta(const LAS unsigned char* At, int lda, const LAS unsigned char* B, int ldb, int nks, f32x4 acc, int lane) {
    const int i = lane & 15, kq = lane >> 4;
    const LAS unsigned char* a = At + (8 * kq + (i >> 2)) * lda + (i & 3) * 8; const LAS unsigned char* b = B + i * ldb + kq * 16;
#pragma unroll
    for (int ks = 0; ks < nks; ++ks) acc = __builtin_amdgcn_mfma_f32_16x16x32_bf16(tr8(a + ks * 32 * lda, 4 * lda), *(const LAS bf16x8*)(b + ks * 64), acc, 0, 0, 0);
    return acc;
}
__device__ __forceinline__ f32x4 mm16_tab(const LAS unsigned char* At, int lda, const LAS unsigned char* Bt, int ldb, int nks, f32x4 acc, int lane) {
    const int i = lane & 15, kq = lane >> 4;
    const LAS unsigned char* a = At + (8 * kq + (i >> 2)) * lda + (i & 3) * 8; const LAS unsigned char* b = Bt + (8 * kq + (i >> 2)) * ldb + (i & 3) * 8;
#pragma unroll
    for (int ks = 0; ks < nks; ++ks) acc = __builtin_amdgcn_mfma_f32_16x16x32_bf16(tr8(a + ks * 32 * lda, 4 * lda), tr8(b + ks * 32 * ldb, 4 * ldb), acc, 0, 0, 0);
    return acc;
}

struct SsdPre { u32x4 px, pb0, pb1, pc0, pc1; u32x2 zv[2]; float pdt; };
struct SsdCtx { const bf16* XBC; bf16* Z; const float* DT; float* SSQ; int row0, nchunks, h, cx, cb, cc; float Ah, Dh; };

struct SsdOff { unsigned x, b0, c0, dt, z0; };
__device__ __forceinline__ void ssd_load(const SsdCtx& X, const SsdOff& O, SsdPre& P, int c) {
    const size_t rb = (size_t)(X.row0 + c * 64);
    const char* xb = (const char*)(X.XBC + rb * CONVD); const char* db = (const char*)(X.DT + rb * 64); const char* zb = (const char*)(X.Z + rb * SSD_IN);
    P.px = __builtin_nontemporal_load((const u32x4*)(xb + O.x));
    P.pb0 = *(const u32x4*)(xb + O.b0); P.pb1 = *(const u32x4*)(xb + O.b0 + 32 * CONVD * 2);
    P.pc0 = *(const u32x4*)(xb + O.c0); P.pc1 = *(const u32x4*)(xb + O.c0 + 32 * CONVD * 2);
    P.pdt = *(const float*)(db + O.dt);
    P.zv[0] = __builtin_nontemporal_load((const u32x2*)(zb + O.z0)); P.zv[1] = __builtin_nontemporal_load((const u32x2*)(zb + O.z0 + 32));
}

template <int CUR> __device__ __forceinline__ void ssd_chunk(LAS unsigned char* L, const SsdCtx& X, const SsdOff& O, SsdPre& P, f32x4 (&Hacc)[4], int c, int tid, int lane, int wave) {
    const int xr = tid >> 3, xc = tid & 7, br = tid >> 4, bc = tid & 15, kq = lane >> 4, l15 = lane & 15, ib = wave >> 1, pbk0 = 2 * (wave & 1), pb = wave >> 1, nb0 = 4 * (wave & 1);
    const int rbase = X.row0 + c * 64;
    LAS unsigned char* SB = L + CUR * SD_BUF;
    const float dtv = P.pdt; float acum = dtv * X.Ah;
#define DPP_ADD(ctrl, rmask) acum += __builtin_bit_cast(float, __builtin_amdgcn_update_dpp(0, __builtin_bit_cast(int, acum), ctrl, rmask, 0xf, false))
    DPP_ADD(0x111, 0xf); DPP_ADD(0x112, 0xf); DPP_ADD(0x114, 0xf); DPP_ADD(0x118, 0xf); DPP_ADD(0x142, 0xa); DPP_ADD(0x143, 0xc);
#undef DPP_ADD
    const float aL = __builtin_bit_cast(float, __builtin_amdgcn_readlane(__builtin_bit_cast(int, acum), 63));
    LAS float* AW = (LAS float*)(L + SD_AW + wave * 512); AW[lane] = acum; AW[64 + lane] = dtv;
    { const float sx = __shfl(dtv, xr) * __expf(aL - __shfl(acum, xr)); const u32x4 px = P.px;
        *(LAS u32x4*)(SB + SDB_XS + xr * 144 + xc * 16) = px;
        u32x4 w; w.x = pk2(bflo(px.x) * sx, bfhi(px.x) * sx); w.y = pk2(bflo(px.y) * sx, bfhi(px.y) * sx); w.z = pk2(bflo(px.z) * sx, bfhi(px.z) * sx); w.w = pk2(bflo(px.w) * sx, bfhi(px.w) * sx);
        *(LAS u32x4*)(SB + SDB_XW + xr * 144 + xc * 16) = w;
        *(LAS u32x4*)(SB + SDB_BS + br * 272 + bc * 16) = P.pb0; *(LAS u32x4*)(SB + SDB_BS + (br + 32) * 272 + bc * 16) = P.pb1;
        *(LAS u32x4*)(SB + SDB_CS + br * 272 + bc * 16) = P.pc0; *(LAS u32x4*)(SB + SDB_CS + (br + 32) * 272 + bc * 16) = P.pc1; }
    const u32x2 zv0 = P.zv[0], zv1 = P.zv[1];
    LBAR();
    if (c + 2 < X.nchunks) ssd_load(X, O, P, c + 2);
    {
        bf16x8 fc[4], fb[2][4], fxw[2], fbt[4][2];
        { const LAS unsigned char* pc = SB + SDB_CS + (16 * ib + l15) * 272 + kq * 16;
#pragma unroll
          for (int ks = 0; ks < 4; ++ks) fc[ks] = *(const LAS bf16x8*)(pc + ks * 64); }
#pragma unroll
        for (int q = 0; q < 2; ++q) { const LAS unsigned char* pbp = SB + SDB_BS + (16 * (2 * (wave & 1) + q) + l15) * 272 + kq * 16;
#pragma unroll
            for (int ks = 0; ks < 4; ++ks) fb[q][ks] = *(const LAS bf16x8*)(pbp + ks * 64); }
        { const LAS unsigned char* pa = SB + SDB_XW + 16 * pb * 2 + (8 * kq + (l15 >> 2)) * 144 + (l15 & 3) * 8;
#pragma unroll
          for (int ks = 0; ks < 2; ++ks) fxw[ks] = tr8(pa + ks * 32 * 144, 4 * 144); }
#pragma unroll
        for (int q = 0; q < 4; ++q) { const LAS unsigned char* pt = SB + SDB_BS + 16 * (nb0 + q) * 2 + (8 * kq + (l15 >> 2)) * 272 + (l15 & 3) * 8;
#pragma unroll
            for (int ks = 0; ks < 2; ++ks) fbt[q][ks] = tr8(pt + ks * 32 * 272, 4 * 272); }
        const float dec = __expf(aL);
        f32x4 cbacc[2];
#pragma unroll
        for (int q = 0; q < 2; ++q) { cbacc[q] = (f32x4){0.f, 0.f, 0.f, 0.f};
#pragma unroll
            for (int ks = 0; ks < 4; ++ks) cbacc[q] = __builtin_amdgcn_mfma_f32_16x16x32_bf16(fb[q][ks], fc[ks], cbacc[q], 0, 0, 0); }
#pragma unroll
        for (int q = 0; q < 4; ++q) { f32x4 acc = Hacc[q] * dec;
#pragma unroll
            for (int ks = 0; ks < 2; ++ks) acc = __builtin_amdgcn_mfma_f32_16x16x32_bf16(fbt[q][ks], fxw[ks], acc, 0, 0, 0);
            Hacc[q] = acc; }
        const int i = 16 * ib + l15; const float ai = AW[i];
#pragma unroll
        for (int q = 0; q < 2; ++q) { const int j0 = 16 * (2 * (wave & 1) + q) + 4 * kq;
            const f32x4 aj = *(const LAS f32x4*)(AW + j0), dj = *(const LAS f32x4*)(AW + 64 + j0);
            float v[4];
#pragma unroll
            for (int r = 0; r < 4; ++r) v[r] = (j0 + r <= i) ? cbacc[q][r] * __expf(ai - aj[r]) * dj[r] : 0.f;
            u32x2 w; w.x = pk2(v[0], v[1]); w.y = pk2(v[2], v[3]);
            *(LAS u32x2*)(L + SD_MS + i * 144 + j0 * 2) = w; }
#pragma unroll
        for (int q = 0; q < 4; ++q) { u32x2 w; w.x = pk2(Hacc[q][0], Hacc[q][1]); w.y = pk2(Hacc[q][2], Hacc[q][3]);
            *(LAS u32x2*)(L + SD_HS + (CUR ^ 1) * 17408 + (16 * pb + l15) * 272 + (16 * (nb0 + q) + 4 * kq) * 2) = w; }
    }
    LBAR();
    {
        const int i = 16 * ib + l15; const float eai = __expf(AW[i]);
        bf16* zrow = (bf16*)((char*)(X.Z + (size_t)rbase * SSD_IN) + O.z0) - 16 * pbk0;
        bf16x8 fms[2], fcs[4], fxs[2][2], fhs[2][4];
        { const LAS unsigned char* pm = L + SD_MS + i * 144 + kq * 16; fms[0] = *(const LAS bf16x8*)pm; fms[1] = *(const LAS bf16x8*)(pm + 64);
          const LAS unsigned char* pc = SB + SDB_CS + i * 272 + kq * 16;
#pragma unroll
          for (int ks = 0; ks < 4; ++ks) fcs[ks] = *(const LAS bf16x8*)(pc + ks * 64); }
#pragma unroll
        for (int q = 0; q < 2; ++q) { const int pbk = pbk0 + q;
            const LAS unsigned char* pa = SB + SDB_XS + 16 * pbk * 2 + (8 * kq + (l15 >> 2)) * 144 + (l15 & 3) * 8;
            fxs[q][0] = tr8(pa, 4 * 144); fxs[q][1] = tr8(pa + 32 * 144, 4 * 144);
            const LAS unsigned char* ph = L + SD_HS + CUR * 17408 + (16 * pbk + l15) * 272 + kq * 16;
#pragma unroll
            for (int ks = 0; ks < 4; ++ks) fhs[q][ks] = *(const LAS bf16x8*)(ph + ks * 64); }
        u32x2 xs2[2];
#pragma unroll
        for (int q = 0; q < 2; ++q) xs2[q] = *(const LAS u32x2*)(SB + SDB_XS + i * 144 + (16 * (pbk0 + q) + 4 * kq) * 2);
        f32x4 a1[2], a2[2];
#pragma unroll
        for (int q = 0; q < 2; ++q) { a1[q] = (f32x4){0.f, 0.f, 0.f, 0.f}; a2[q] = (f32x4){0.f, 0.f, 0.f, 0.f};
#pragma unroll
            for (int ks = 0; ks < 2; ++ks) a1[q] = __builtin_amdgcn_mfma_f32_16x16x32_bf16(fxs[q][ks], fms[ks], a1[q], 0, 0, 0);
#pragma unroll
            for (int ks = 0; ks < 4; ++ks) a2[q] = __builtin_amdgcn_mfma_f32_16x16x32_bf16(fhs[q][ks], fcs[ks], a2[q], 0, 0, 0); }
#pragma unroll
        for (int q = 0; q < 2; ++q) { const int pbk = pbk0 + q; const u32x2 zz = q ? zv1 : zv0; const u32x2 xs = xs2[q];
            float y0 = a1[q][0] + eai * a2[q][0] + X.Dh * bflo(xs.x), y1 = a1[q][1] + eai * a2[q][1] + X.Dh * bfhi(xs.x), y2 = a1[q][2] + eai * a2[q][2] + X.Dh * bflo(xs.y), y3 = a1[q][3] + eai * a2[q][3] + X.Dh * bfhi(xs.y);
            y0 *= siluf_(bflo(zz.x)); y1 *= siluf_(bfhi(zz.x)); y2 *= siluf_(bflo(zz.y)); y3 *= siluf_(bfhi(zz.y));
            u32x2 w; w.x = pk2(y0, y1); w.y = pk2(y2, y3);
            *(u32x2*)(zrow + 16 * pbk) = w;
            float s = (y0 * y0 + y1 * y1) + (y2 * y2 + y3 * y3); s += __shfl_xor(s, 16); s += __shfl_xor(s, 32);
            if (kq == 0) ((LAS float*)(L + SD_SSQ + CUR * 1024))[i * 4 + pbk] = s; }
    }
    if (c > 0 && tid < 64) { const LAS float* sp = (const LAS float*)(L + SD_SSQ + (CUR ^ 1) * 1024) + tid * 4; X.SSQ[(size_t)(rbase - 64 + tid) * 64 + X.h] = (sp[0] + sp[1]) + (sp[2] + sp[3]); }
}

__device__ __forceinline__ void ssd_unit(Frame& F, int row0, int nchunks, int h, const float* h0, float* hout) {
    LAS unsigned char* L = F.lds; const int tid = F.tid, lane = F.lane, wave = F.wave;
    unsigned char* ws = F.ws;
    SsdCtx X; X.XBC = (const bf16*)(ws + WS_XBC); X.Z = (bf16*)(ws + WS_Z); X.DT = (const float*)(ws + WS_DT); X.SSQ = (float*)(ws + WS_SSQ);
    X.row0 = row0; X.nchunks = nchunks; X.h = h; X.cx = h * 64; X.cb = SSD_IN + (h >> 3) * 128; X.cc = SSD_IN + 1024 + (h >> 3) * 128;
    X.Ah = -__expf(F.in[16][h]); X.Dh = F.in[17][h];
    __syncthreads();
    f32x4 Hacc[4]; const int pb = wave >> 1, nb0 = 4 * (wave & 1), kq = lane >> 4, l15 = lane & 15;
#pragma unroll
    for (int q = 0; q < 4; ++q) {
#pragma unroll
        for (int r = 0; r < 4; ++r) { const int p = 16 * pb + l15, n = 16 * (nb0 + q) + 4 * kq + r; const float v = h0 ? h0[p * 128 + n] : 0.f; Hacc[q][r] = v;
            *((LAS bf16*)(L + SD_HS + p * 272) + n) = (bf16)f2bf(v); } }
    SsdOff O;
    { const int xr = tid >> 3, xc = tid & 7, br = tid >> 4, bc = tid & 15, ib = wave >> 1, pbk0 = 2 * (wave & 1);
      O.x = (unsigned)(xr * CONVD + X.cx + xc * 8) * 2u; O.b0 = (unsigned)(br * CONVD + X.cb + bc * 8) * 2u; O.c0 = (unsigned)(br * CONVD + X.cc + bc * 8) * 2u;
      O.dt = (unsigned)(lane * 64 + h) * 4u; O.z0 = (unsigned)((16 * ib + l15) * SSD_IN + h * 64 + 4 * kq + 16 * pbk0) * 2u; }
    SsdPre PA, PB;
    ssd_load(X, O, PA, 0);
    if (nchunks > 1) ssd_load(X, O, PB, 1);
    for (int c = 0; c < nchunks; c += 2) {
        ssd_chunk<0>(L, X, O, PA, Hacc, c, tid, lane, wave);
        if (c + 1 < nchunks) ssd_chunk<1>(L, X, O, PB, Hacc, c + 1, tid, lane, wave);
    }
    LBAR();
    if (tid < 64) { const LAS float* sp = (const LAS float*)(L + SD_SSQ + ((nchunks - 1) & 1) * 1024) + tid * 4; X.SSQ[(size_t)(row0 + (nchunks - 1) * 64 + tid) * 64 + h] = (sp[0] + sp[1]) + (sp[2] + sp[3]); }
#pragma unroll
    for (int q = 0; q < 4; ++q)
#pragma unroll
        for (int r = 0; r < 4; ++r) hout[(16 * pb + l15) * 128 + 16 * (nb0 + q) + 4 * kq + r] = Hacc[q][r];
}

__device__ __forceinline__ void p6_ssd(Frame& F) {
    const int bx = blockIdx.x; const int vcu = (F.G % 8 == 0) ? (bx % 8) * (F.G / 8) + bx / 8 : bx;
    for (int u = vcu; u < NBP * SSD_H; u += F.G) { const int b = u >> 6, h = u & 63;
        ssd_unit(F, b * SEQP, SEQP / 64, h, nullptr, F.out + O_SSD_P + (size_t)u * 8192); }
    for (int u = vcu; u < NBS * SSD_H; u += F.G) { const int b = u >> 6, h = u & 63;
        ssd_unit(F, MP + b * 64, 1, h, F.in[5] + (size_t)u * 8192, F.out + O_SSD_S + (size_t)u * 8192); }
}

__device__ __forceinline__ void p7_ynorm(Frame& F) {
    const int gw = blockIdx.x * NWAVES + F.wave, NGW = F.G * NWAVES, lane = F.lane;
    bf16* Y = (bf16*)(F.ws + WS_Z); const float* SSQ = (const float*)(F.ws + WS_SSQ);
    for (int r = gw; r < MT; r += NGW) {
        float s = SSQ[(size_t)r * 64 + lane];
        s += __shfl_xor(s, 1); s += __shfl_xor(s, 2); s += __shfl_xor(s, 4);
        const float rstd = 1.0f / sqrtf(s * (1.f / 512.f) + EPS);
        u32x4* yr = (u32x4*)(Y + (size_t)r * SSD_IN) + lane;
#pragma unroll
        for (int j = 0; j < 8; ++j) { const float rs = __shfl(rstd, 8 * j); u32x4 v = yr[64 * j];
            v.x = pk2(bflo(v.x) * rs, bfhi(v.x) * rs); v.y = pk2(bflo(v.y) * rs, bfhi(v.y) * rs); v.z = pk2(bflo(v.z) * rs, bfhi(v.z) * rs); v.w = pk2(bflo(v.w) * rs, bfhi(v.w) * rs);
            yr[64 * j] = v; }
    }
}
__device__ __forceinline__ void part_sum8(const float* part, int nsl, int r, int c, float (&v)[8]) {
    const float* p = part + (size_t)r * nsl * 2048 + c;
#pragma unroll
    for (int e = 0; e < 8; ++e) v[e] = 0.f;
    for (int sl = 0; sl < nsl; ++sl) { const f32x4 a = *(const f32x4*)(p + sl * 2048), b = *(const f32x4*)(p + sl * 2048 + 4);
#pragma unroll
        for (int e = 0; e < 4; ++e) { v[e] += a[e]; v[4 + e] += b[e]; } }
}
__device__ __forceinline__ void p9b_ossd_sample(Frame& F) {
    const int gw = blockIdx.x * NWAVES + F.wave, NGW = F.G * NWAVES, lane = F.lane;
    bf16* OS = (bf16*)(F.ws + WS_OSSD); const float* part = (const float*)(F.ws + WS_XH);
    for (int r = gw; r < MS; r += NGW) { const size_t row = (size_t)(MP + r);
#pragma unroll
        for (int j = 0; j < 4; ++j) { const int c = 512 * j + 8 * lane; float sv[8]; part_sum8(part, 8, r, c, sv);
            u32x4 w; w.x = pk2(sv[0], sv[1]); w.y = pk2(sv[2], sv[3]); w.z = pk2(sv[4], sv[5]); w.w = pk2(sv[6], sv[7]);
            *(u32x4*)(OS + row * 2048 + c) = w; }
    }
}
__device__ __forceinline__ void p10_x1(Frame& F) {
    const int gw = blockIdx.x * NWAVES + F.wave, NGW = F.G * NWAVES, lane = F.lane;
    const float* g1 = F.in[22]; const float* g2 = F.in[23];
    for (int r = gw; r < MT; r += NGW) {
        const u32x4* mr = (const u32x4*)((const bf16*)(F.ws + WS_Z) + (size_t)r * DM) + lane; const float* xr = x_row(F, r);
        float v[4][8]; float s = 0.f;
#pragma unroll
        for (int j = 0; j < 4; ++j) {
            if (r < MP) { const u32x4 m = __builtin_nontemporal_load(mr + 64 * j);
#pragma unroll
                for (int e = 0; e < 4; ++e) { v[j][2 * e] = bflo(m[e]); v[j][2 * e + 1] = bfhi(m[e]); } }
            else part_sum8((const float*)(F.ws + WS_XH), 8, r - MP, 512 * j + 8 * lane, v[j]);
#pragma unroll
            for (int e = 0; e < 8; ++e) s += v[j][e] * v[j][e]; }
        const float rstd = 1.0f / sqrtf(wave_sum(s) * (1.f / DM) + EPS);
        float s2 = 0.f;
#pragma unroll
        for (int j = 0; j < 4; ++j) { const int c = 512 * j + 8 * lane; const f32x4 x0 = __builtin_nontemporal_load((const f32x4*)(xr + c)), x1 = __builtin_nontemporal_load((const f32x4*)(xr + c + 4)), ga = *(const f32x4*)(g1 + c), gb = *(const f32x4*)(g1 + c + 4);
            f32x4 o0, o1;
#pragma unroll
            for (int e = 0; e < 4; ++e) { o0[e] = x0[e] + v[j][e] * rstd * ga[e]; o1[e] = x1[e] + v[j][4 + e] * rstd * gb[e]; v[j][e] = o0[e]; v[j][4 + e] = o1[e]; s2 += o0[e] * o0[e] + o1[e] * o1[e]; }
            u32x4 wx; wx.x = pk2(o0[0], o0[1]); wx.y = pk2(o0[2], o0[3]); wx.z = pk2(o1[0], o1[1]); wx.w = pk2(o1[2], o1[3]);
            *((u32x4*)(F.out + O_Y + (size_t)r * DM) + 64 * j + lane) = wx; }
        const float rstd2 = 1.0f / sqrtf(wave_sum(s2) * (1.f / DM) + EPS);
        u32x4* o8 = (u32x4*)((bf16*)(F.ws + WS_U) + (size_t)r * DM) + lane;
#pragma unroll
        for (int j = 0; j < 4; ++j) { const int c = 512 * j + 8 * lane; const f32x4 ga = *(const f32x4*)(g2 + c), gb = *(const f32x4*)(g2 + c + 4);
            u32x4 w; w.x = pk2(v[j][0] * rstd2 * ga[0], v[j][1] * rstd2 * ga[1]); w.y = pk2(v[j][2] * rstd2 * ga[2], v[j][3] * rstd2 * ga[3]);
            w.z = pk2(v[j][4] * rstd2 * gb[0], v[j][5] * rstd2 * gb[1]); w.w = pk2(v[j][6] * rstd2 * gb[2], v[j][7] * rstd2 * gb[3]); o8[64 * j] = w; }
    }
}
__device__ __forceinline__ void p12_convgate(Frame& F) {
    const int gw = blockIdx.x * NWAVES + F.wave, NGW = F.G * NWAVES, lane = F.lane;
    bf16* UA = (bf16*)(F.ws + WS_UPA); const bf16* UB = (const bf16*)(F.ws + WS_UPB); const bf16* HALO = (const bf16*)(F.ws + WS_HALO);
    const float* cw = F.in[25]; const float* cbv = F.in[26];
    constexpr int NCH = MT / 64, NSL = DFF / 512;
    for (int u = gw; u < NCH * NSL; u += NGW) {
        const int ch = u / NSL, sl = u - ch * NSL, col = sl * 512 + lane * 8;
        float wa[3][8], wb[3][8], ba[8], bb[8];
#pragma unroll
        for (int k = 0; k < 3; ++k) { const f32x4 a0 = *(const f32x4*)(cw + k * 2 * DFF + col), a1 = *(const f32x4*)(cw + k * 2 * DFF + col + 4), b0 = *(const f32x4*)(cw + k * 2 * DFF + DFF + col), b1 = *(const f32x4*)(cw + k * 2 * DFF + DFF + col + 4);
#pragma unroll
            for (int e = 0; e < 4; ++e) { wa[k][e] = a0[e]; wa[k][4 + e] = a1[e]; wb[k][e] = b0[e]; wb[k][4 + e] = b1[e]; } }
        { const f32x4 a0 = *(const f32x4*)(cbv + col), a1 = *(const f32x4*)(cbv + col + 4), b0 = *(const f32x4*)(cbv + DFF + col), b1 = *(const f32x4*)(cbv + DFF + col + 4);
#pragma unroll
            for (int e = 0; e < 4; ++e) { ba[e] = a0[e]; ba[4 + e] = a1[e]; bb[e] = b0[e]; bb[4 + e] = b1[e]; } }
        float a_m2[8], a_m1[8], b_m2[8], b_m1[8];
        const bool first = ch < MP / 64 ? ((ch & 127) == 0) : true;
        const bool last = ch < MP / 64 ? ((ch & 127) == 127) : true;
        if (first) {
            if (ch < MP / 64) {
#pragma unroll
                for (int e = 0; e < 8; ++e) { a_m2[e] = 0.f; a_m1[e] = 0.f; b_m2[e] = 0.f; b_m1[e] = 0.f; }
            } else { const float* hs = F.in[6] + (size_t)(ch - MP / 64) * 2 * 2 * DFF;
#pragma unroll
                for (int e = 0; e < 8; ++e) { a_m2[e] = hs[col + e]; a_m1[e] = hs[2 * DFF + col + e]; b_m2[e] = hs[DFF + col + e]; b_m1[e] = hs[2 * DFF + DFF + col + e]; } }
        } else { const bf16* hp = HALO + (size_t)(ch - 1) * 2 * 2 * DFF;
            const u32x4 x0 = *(const u32x4*)(hp + col), x1 = *(const u32x4*)(hp + 2 * DFF + col), y0 = *(const u32x4*)(hp + DFF + col), y1 = *(const u32x4*)(hp + 2 * DFF + DFF + col);
#pragma unroll
            for (int e = 0; e < 4; ++e) { a_m2[2 * e] = bflo(x0[e]); a_m2[2 * e + 1] = bfhi(x0[e]); a_m1[2 * e] = bflo(x1[e]); a_m1[2 * e + 1] = bfhi(x1[e]);
                b_m2[2 * e] = bflo(y0[e]); b_m2[2 * e + 1] = bfhi(y0[e]); b_m1[2 * e] = bflo(y1[e]); b_m1[2 * e + 1] = bfhi(y1[e]); } }
        float* oc = nullptr;
        if (last) oc = ch < MP / 64 ? F.out + O_FCONV_P + (size_t)(ch >> 7) * 2 * 2 * DFF : F.out + O_FCONV_S + (size_t)(ch - MP / 64) * 2 * 2 * DFF;
        for (int tb = 0; tb < 64; tb += 8) {
            u32x4 ra[8], rb[8];
#pragma unroll
            for (int i = 0; i < 8; ++i) { const size_t ro = (size_t)(ch * 64 + tb + i) * DFF + col; ra[i] = __builtin_nontemporal_load((const u32x4*)(UA + ro)); rb[i] = __builtin_nontemporal_load((const u32x4*)(UB + ro)); }
#pragma unroll
            for (int i = 0; i < 8; ++i) {
                const int t = tb + i; const size_t ro = (size_t)(ch * 64 + t) * DFF + col;
                float a0[8], b0[8]; u32x4 w;
#pragma unroll
                for (int e = 0; e < 4; ++e) { a0[2 * e] = bflo(ra[i][e]); a0[2 * e + 1] = bfhi(ra[i][e]); b0[2 * e] = bflo(rb[i][e]); b0[2 * e + 1] = bfhi(rb[i][e]); }
                float hv[8];
#pragma unroll
                for (int e = 0; e < 8; ++e) { const float ca = ba[e] + wa[0][e] * a_m2[e] + wa[1][e] * a_m1[e] + wa[2][e] * a0[e]; const float cb2 = bb[e] + wb[0][e] * b_m2[e] + wb[1][e] * b_m1[e] + wb[2][e] * b0[e];
                    hv[e] = siluf_(ca) * cb2; a_m2[e] = a_m1[e]; a_m1[e] = a0[e]; b_m2[e] = b_m1[e]; b_m1[e] = b0[e]; }
                w.x = pk2(hv[0], hv[1]); w.y = pk2(hv[2], hv[3]); w.z = pk2(hv[4], hv[5]); w.w = pk2(hv[6], hv[7]);
                *(u32x4*)(UA + ro) = w;
                if (oc && t >= 62) { float* o = oc + (size_t)(t - 62) * 2 * DFF + col;
#pragma unroll
                    for (int e = 0; e < 8; ++e) { o[e] = a0[e]; o[DFF + e] = b0[e]; } }
            }
        }
    }
}
__device__ __forceinline__ void p14_final(Frame& F) {
    const int gw = blockIdx.x * NWAVES + F.wave, NGW = F.G * NWAVES, lane = F.lane;
    const float* g1 = F.in[28];
    for (int r = gw; r < MT; r += NGW) {
        float* orow = F.out + O_Y + (size_t)r * DM; const u32x4* dr = (const u32x4*)((const bf16*)(F.ws + WS_DN) + (size_t)r * DM) + lane;
        u32x4 xq[4];
#pragma unroll
        for (int j = 0; j < 4; ++j) xq[j] = __builtin_nontemporal_load((const u32x4*)orow + 64 * j + lane);
        float v[4][8]; float s = 0.f;
#pragma unroll
        for (int j = 0; j < 4; ++j) {
            if (r < MP) { const u32x4 m = __builtin_nontemporal_load(dr + 64 * j);
#pragma unroll
                for (int e = 0; e < 4; ++e) { v[j][2 * e] = bflo(m[e]); v[j][2 * e + 1] = bfhi(m[e]); } }
            else part_sum8((const float*)(F.ws + WS_XH), 11, r - MP, 512 * j + 8 * lane, v[j]);
#pragma unroll
            for (int e = 0; e < 8; ++e) s += v[j][e] * v[j][e]; }
        const float rstd = 1.0f / sqrtf(wave_sum(s) * (1.f / DM) + EPS);
#pragma unroll
        for (int j = 0; j < 4; ++j) { const int c = 512 * j + 8 * lane; const f32x4 ga = *(const f32x4*)(g1 + c), gb = *(const f32x4*)(g1 + c + 4);
            const u32x4 xb = xq[j];
            f32x4 o0 = {bflo(xb.x), bfhi(xb.x), bflo(xb.y), bfhi(xb.y)}, o1 = {bflo(xb.z), bfhi(xb.z), bflo(xb.w), bfhi(xb.w)};
#pragma unroll
            for (int e = 0; e < 4; ++e) { o0[e] += v[j][e] * rstd * ga[e]; o1[e] += v[j][4 + e] * rstd * gb[e]; }
            __builtin_nontemporal_store(o0, (f32x4*)(orow + c)); __builtin_nontemporal_store(o1, (f32x4*)(orow + c + 4)); }
    }
}

#ifndef GEMM_REP
#define GEMM_REP 1
#endif
#ifndef GEMM_ALIGN
#define GEMM_ALIGN true
#endif
#ifndef GEMM_SP2
#define GEMM_SP2 true
#endif
constexpr int NPH = 16;
__global__ void __launch_bounds__(NWAVES * 64, 2) hybrid_fwd(Args args) {
    extern __shared__ __attribute__((aligned(16))) unsigned char lds_raw[];
    cg::grid_group grid = cg::this_grid();
    Frame F;
    F.lds = (LAS unsigned char*)lds_raw;
    F.tid = threadIdx.x; F.lane = F.tid & 63; F.wave = __builtin_amdgcn_readfirstlane(F.tid >> 6);
    F.G = gridDim.x; F.in = args.in; F.out = args.out; F.ws = args.ws;
    unsigned char* ws = args.ws;
    const int lo = args.ph_lo, hi = args.ph_hi;
    volatile LAS unsigned* bst = (volatile LAS unsigned*)(F.lds + LDS_BYTES - 64);
    if (F.tid == 0) { bst[0] = 0u; bst[1] = 0u; }
    __syncthreads();
    XcdBarrier xbar = xcd_barrier_post((unsigned*)ws, bst);
#define GSYNC() xcd_barrier(xbar)
#ifndef PHMASK
#define PHMASK 0xFFFF
#endif
#define IN(k) (((PHMASK >> (k)) & 1) && lo <= (k) && (k) < hi)
#define SEAM(k) do { if (IN(k) && IN((k) + 1)) GSYNC(); } while (0)
    if (hi < 0) grid.sync();
    using namespace pg8;
    const int bx = (int)blockIdx.x;
    if (IN(0)) { p0_prologue(F);
#if defined(PROBE_P0)
        __syncthreads(); p0_prologue(F);
#endif
    } SEAM(0);
    if (IN(1)) {
        Gemm g{(const bf16_t*)(ws + WS_U), (const bf16_t*)(ws + WS_WIN), MT, S1N, 2048}; StaticOrder S; S.init(MT, S1N, F.G, bx);
        EpiF32 E{(float*)(ws + WS_P1), S1N};
        gemm_phase<EpiF32, StaticOrder, GEMM_ALIGN, GEMM_SP2>(F.lds, g, S, E);
    } SEAM(1);
    if (IN(2)) { p2_mla_prep(F); } SEAM(2);
    if (IN(3)) {
        { Gemm g{(const bf16_t*)(ws + WS_CQN), (const bf16_t*)(ws + WS_WUQ), MT, 3072, 512}; StaticOrder S; S.init(MT, 3072, F.G, bx);
          EpiQ E{(bf16_t*)(ws + WS_QN), (bf16_t*)(ws + WS_QP), (const float*)(ws + WS_ROPE)};
          gemm_phase<EpiQ, StaticOrder, GEMM_ALIGN, GEMM_SP2>(F.lds, g, S, E); }
        { Gemm g{(const bf16_t*)(ws + WS_CKVB), (const bf16_t*)(ws + WS_WUKV), KVR, 4096, 512}; StaticOrder S; S.init(KVR, 4096, F.G, F.G - 1 - bx);
          EpiBf16S<0, 0> E{(bf16_t*)(ws + WS_KN), 2048, 8, (bf16_t*)(ws + WS_V), 2048, nullptr, 0, 1.0f, 1};
          gemm_phase<EpiBf16S<0, 0>, StaticOrder, GEMM_ALIGN, GEMM_SP2>(F.lds, g, S, E); }
    } SEAM(3);
    if (IN(4)) {
#if defined(PROBE_ATT2)
        p4_attention(F, (bf16*)(F.out + O_Y));
#endif
        p4_attention(F, nullptr); } SEAM(4);
    if (IN(5)) {
        { Gemm g{(const bf16_t*)(ws + WS_QN), (const bf16_t*)(ws + WS_WOMLA), MT, 2048, 2048}; StaticOrder S; S.init(MT, 2048, F.G, bx);
          EpiBf16S<0, 0> E{(bf16_t*)(F.out + O_Y), 2048, 1 << 20, nullptr, 0, nullptr, 0, 1.0f};
          gemm_phase<EpiBf16S<0, 0>, StaticOrder, GEMM_ALIGN, GEMM_SP2>(F.lds, g, S, E); }
        { Gemm g{(const bf16_t*)(ws + WS_U), (const bf16_t*)(ws + WS_WIN) + (size_t)S1N * 2048, MT, 4096, 2048}; StaticOrder S; S.init(MT, 4096, F.G, F.G - 1 - bx);
          EpiBf16S<0, 0> E{(bf16_t*)(ws + WS_Z), 4096, 1 << 20, nullptr, 0, nullptr, 0, 1.0f, 1};
          gemm_phase<EpiBf16S<0, 0>, StaticOrder, GEMM_ALIGN, GEMM_SP2>(F.lds, g, S, E); }
    } SEAM(5);
    if (IN(6)) {
        Gemm g{(const bf16_t*)(ws + WS_U), (const bf16_t*)(ws + WS_WIN) + (size_t)(S1N + 4096) * 2048, MT, 6144, 2048}; StaticOrder S; S.init(MT, 6144, F.G, bx);
        EpiBf16S<0, 3> E{(bf16_t*)(ws + WS_XBC), 6144, 1 << 20, nullptr, 0, (bf16_t*)(ws + WS_XH), 6144, 1.0f, 1};
        gemm_phase<EpiBf16S<0, 3>, StaticOrder, GEMM_ALIGN, GEMM_SP2>(F.lds, g, S, E);
    } SEAM(6);
    if (IN(7)) { p6a_conv(F); GSYNC();
        p6_ssd(F); } SEAM(7);
    if (IN(8)) { p7_ynorm(F); } SEAM(8);
    if (IN(9)) {
        { Gemm g{(const bf16_t*)(ws + WS_Z), (const bf16_t*)(ws + WS_WOSSD), MP, 2048, 4096}; StaticOrder S; S.init(MP, 2048, F.G, bx);
          EpiBf16S<0, 0> E{(bf16_t*)(ws + WS_OSSD), 2048, 1 << 20, nullptr, 0, nullptr, 0, 1.0f};
          gemm_phase<EpiBf16S<0, 0>, StaticOrder, GEMM_ALIGN, GEMM_SP2>(F.lds, g, S, E); }
        { Gemm g{(const bf16_t*)(ws + WS_Z) + (size_t)MP * 4096, (const bf16_t*)(ws + WS_WOSSD), MS, 8 * 2048, 512, 4096, 8, 512}; StaticOrder S; S.init(MS, 8 * 2048, F.G, F.G - 1 - bx);
          EpiF32 E{(float*)(ws + WS_XH), 8 * 2048};
          gemm_phase<EpiF32, StaticOrder, GEMM_ALIGN, GEMM_SP2>(F.lds, g, S, E); }
    } SEAM(9);
    if (IN(10)) {
        p9b_ossd_sample(F); GSYNC();
        { Gemm g{(const bf16_t*)(ws + WS_U), (const bf16_t*)(ws + WS_WIN) + (size_t)(S1N + S2N) * 2048, MT, 4096, 2048}; StaticOrder S; S.init(MT, 4096, F.G, bx);
          EpiGateMerge E{(bf16_t*)(ws + WS_MRG), (const bf16_t*)(F.out + O_Y), (const bf16_t*)(ws + WS_OSSD)};
          gemm_phase<EpiGateMerge, StaticOrder, GEMM_ALIGN, GEMM_SP2>(F.lds, g, S, E); }
        GSYNC();
        { Gemm g{(const bf16_t*)(ws + WS_MRG), (const bf16_t*)(ws + WS_WOUT), MP, 2048, 2048}; StaticOrder S; S.init(MP, 2048, F.G, bx);
          EpiBf16S<0, 0> E{(bf16_t*)(ws + WS_Z), 2048, 1 << 20, nullptr, 0, nullptr, 0, 1.0f};
          gemm_phase<EpiBf16S<0, 0>, StaticOrder, GEMM_ALIGN, GEMM_SP2>(F.lds, g, S, E); }
        { Gemm g{(const bf16_t*)(ws + WS_MRG) + (size_t)MP * 2048, (const bf16_t*)(ws + WS_WOUT), MS, 8 * 2048, 256, 2048, 8, 256}; StaticOrder S; S.init(MS, 8 * 2048, F.G, F.G - 1 - bx);
          EpiF32 E{(float*)(ws + WS_XH), 8 * 2048};
          gemm_phase<EpiF32, StaticOrder, GEMM_ALIGN, GEMM_SP2>(F.lds, g, S, E); }
    } SEAM(10);
    if (IN(11)) { p10_x1(F); } SEAM(11);
    if (IN(12)) {
        Gemm g{(const bf16_t*)(ws + WS_U), (const bf16_t*)(ws + WS_WUP), MT, 2 * DFF, 2048}; StaticOrder S; S.init(MT, 2 * DFF, F.G, bx);
        EpiBf16S<0, 2> E{(bf16_t*)(ws + WS_UPA), DFF, DFF / 256, (bf16_t*)(ws + WS_UPB), DFF, (bf16_t*)(ws + WS_HALO), 2 * DFF, 1.0f, 1};
        gemm_phase<EpiBf16S<0, 2>, StaticOrder, GEMM_ALIGN, GEMM_SP2>(F.lds, g, S, E);
    } SEAM(12);
    if (IN(13)) { p12_convgate(F); } SEAM(13);
    if (IN(14)) {
        { Gemm g{(const bf16_t*)(ws + WS_UPA), (const bf16_t*)(ws + WS_WDN), MP, 2048, DFF}; StaticOrder S; S.init(MP, 2048, F.G, bx);
          EpiBf16S<0, 0> E{(bf16_t*)(ws + WS_DN), 2048, 1 << 20, nullptr, 0, nullptr, 0, 1.0f};
          gemm_phase<EpiBf16S<0, 0>, StaticOrder, GEMM_ALIGN, GEMM_SP2>(F.lds, g, S, E); }
        { Gemm g{(const bf16_t*)(ws + WS_UPA) + (size_t)MP * DFF, (const bf16_t*)(ws + WS_WDN), MS, 11 * 2048, 512, DFF, 8, 512}; StaticOrder S; S.init(MS, 11 * 2048, F.G, F.G - 1 - bx);
          EpiF32 E{(float*)(ws + WS_XH), 11 * 2048};
          gemm_phase<EpiF32, StaticOrder, GEMM_ALIGN, GEMM_SP2>(F.lds, g, S, E); }
    } SEAM(14);
#if defined(PROBE_SYNC)
    for (int q_ = 0; q_ < 16; ++q_) GSYNC();
#endif
    if (IN(15)) { p14_final(F); }
#undef IN
#undef SEAM
}

extern "C" void kernel_launch(void* const* d_in, const int* in_sizes, int n_in, void* d_out, int out_size, void* d_ws, size_t ws_size, hipStream_t stream) {
    static int grid = 0;
    if (grid == 0) {
        if (n_in != 29 || (size_t)out_size != O_TOTAL || ws_size < WS_END) { fprintf(stderr, "kernel_launch: unexpected shapes: n_in %d out %d ws %zu (need >= %zu)\n", n_in, out_size, ws_size, (size_t)WS_END); grid = -1; return; }
        int dev = 0, cus = 0, per_cu = 0;
        if (hipGetDevice(&dev) != hipSuccess || hipDeviceGetAttribute(&cus, hipDeviceAttributeMultiprocessorCount, dev) != hipSuccess) { grid = -1; return; }
        if (hipFuncSetAttribute((const void*)hybrid_fwd, hipFuncAttributeMaxDynamicSharedMemorySize, LDS_BYTES) != hipSuccess) { fprintf(stderr, "kernel_launch: hipFuncSetAttribute failed\n"); grid = -1; return; }
        if (hipOccupancyMaxActiveBlocksPerMultiprocessor(&per_cu, (const void*)hybrid_fwd, NWAVES * 64, LDS_BYTES) != hipSuccess || per_cu < 1) { fprintf(stderr, "kernel_launch: occupancy query says %d\n", per_cu); per_cu = 1; }
        (void)hipGetLastError();
        grid = cus * 1;
    }
    if (grid < 0) return;
    if (hipMemsetAsync(d_ws, 0, 16384, stream) != hipSuccess) { fprintf(stderr, "kernel_launch: hipMemsetAsync failed\n"); return; }
    Args a{};
    for (int i = 0; i < 29; ++i) a.in[i] = (const float*)d_in[i];
    a.out = (float*)d_out; a.ws = (unsigned char*)d_ws;
#if defined(MK_MULTI)
    for (int p = 0; p < NPH; ++p) { a.ph_lo = p; a.ph_hi = p + 1; hipLaunchKernelGGL(hybrid_fwd, dim3(grid), dim3(NWAVES * 64), LDS_BYTES, stream, a); }
#else
    a.ph_lo = 0; a.ph_hi = NPH;
    void* kargs[] = {&a};
    hipError_t e = hipLaunchCooperativeKernel((const void*)hybrid_fwd, dim3(grid), dim3(NWAVES * 64), kargs, LDS_BYTES, stream);
    if (e != hipSuccess) fprintf(stderr, "kernel_launch: cooperative launch failed: %s (grid %d)\n", hipGetErrorString(e), grid);
#endif
}
```

```cpp
#include <hip/hip_runtime.h>
#include <hip/hip_cooperative_groups.h>
#include <cstdio>
#include <cstdint>
namespace cg = cooperative_groups;

constexpr int DM = 2048, SEQP = 8192, NBP = 4, NBS = 8, LSAMP = 64, PAST = 2048;
constexpr int MP = NBP * SEQP;
constexpr int MS = NBS * LSAMP;
constexpr int MT = MP + MS;
constexpr int KVS = PAST + LSAMP;
constexpr int KVR = MP + NBS * KVS;
constexpr int QLORA = 512, KVLORA = 512, ROPE = 64, NOPE = 128, VHD = 128, NH = 16;
constexpr int SSD_IN = 4096, SSD_H = 64, SSD_P = 64, SSD_G = 8, SSD_N = 128, CONVD = 6144;
constexpr int DFF = 5632;
constexpr int OFF_Q = 0, OFF_KV = 512, OFF_Z = 1088, OFF_XBC = 5184, OFF_DT = 11328, OFF_GATE = 11392, IN_DIM = 15488;
constexpr int S1N = 1280;
constexpr int S2N = 10240;
constexpr int S3N = 4096;
constexpr int WIN_ROWS = S1N + S2N + S3N;
constexpr float EPS = 1e-6f;
constexpr float QSCALE = 0.07216878364870322f * 1.4426950408889634f;

constexpr size_t O_Y = 0;
constexpr size_t O_CKV_P = (size_t)MT * DM;
constexpr size_t O_KPE_P = O_CKV_P + (size_t)MP * 512;
constexpr size_t O_SCONV_P = O_KPE_P + (size_t)MP * 64;
constexpr size_t O_SSD_P = O_SCONV_P + (size_t)NBP * 3 * CONVD;
constexpr size_t O_FCONV_P = O_SSD_P + (size_t)NBP * 64 * 64 * 128;
constexpr size_t O_CKV_S = O_FCONV_P + (size_t)NBP * 2 * 2 * DFF;
constexpr size_t O_KPE_S = O_CKV_S + (size_t)MS * 512;
constexpr size_t O_SCONV_S = O_KPE_S + (size_t)MS * 64;
constexpr size_t O_SSD_S = O_SCONV_S + (size_t)NBS * 3 * CONVD;
constexpr size_t O_FCONV_S = O_SSD_S + (size_t)NBS * 64 * 64 * 128;
constexpr size_t O_TOTAL = O_FCONV_S + (size_t)NBS * 2 * 2 * DFF;
static_assert(O_TOTAL == 94109696, "d_out size");

constexpr size_t MiB = 1u << 20;
constexpr size_t WS_ROPE = 1 * MiB;
constexpr size_t WS_WUP = 4 * MiB, WS_WDN = 48 * MiB;
constexpr size_t WS_U = 70 * MiB;
constexpr size_t WS_DT = 200 * MiB;
constexpr size_t WS_SSQ = 208 * MiB + 512 * 1024;
constexpr size_t WS_P1 = 220 * MiB;
constexpr size_t WS_KN = 220 * MiB;
constexpr size_t WS_CKVB = 415 * MiB;
constexpr size_t WS_KPEB = 463 * MiB + 512 * 1024;
constexpr size_t WS_QN = 470 * MiB;
constexpr size_t WS_QP = 600 * MiB;
constexpr size_t WS_CQN = 665 * MiB;
constexpr size_t WS_V = 697 * MiB + 512 * 1024;
constexpr size_t WS_XBC = 217 * MiB;
constexpr size_t WS_Z = 607 * MiB;
constexpr size_t WS_G = 217 * MiB;
constexpr size_t WS_MRG = 217 * MiB;
constexpr size_t WS_OSSD = 477 * MiB;
constexpr size_t WS_UPA = 200 * MiB;
constexpr size_t WS_UPB = 557 * MiB + 512 * 1024;
constexpr size_t WS_HALO = 915 * MiB;
constexpr size_t WS_XH = 868 * MiB;
constexpr size_t WS_DN = 557 * MiB + 512 * 1024;
constexpr size_t WS_WIN = 924 * MiB, WS_WUQ = 985 * MiB, WS_WUKV = 988 * MiB, WS_WOMLA = 992 * MiB, WS_WOSSD = 1000 * MiB, WS_WOUT = 1016 * MiB;
constexpr size_t WS_END = 1024 * MiB;
static_assert(WS_WIN + (size_t)WIN_ROWS * 2048 * 2 <= WS_WUQ, "w_in_t");
static_assert(WS_KN + (size_t)KVR * 2048 * 2 <= WS_CKVB && WS_V + (size_t)KVR * 2048 * 2 <= WS_WIN, "kn/v");
static_assert(WS_XBC + (size_t)MT * 6144 * 2 <= WS_Z && WS_Z + (size_t)MT * 4096 * 2 <= WS_WIN, "z/xbc");
static_assert(WS_UPA + (size_t)MT * DFF * 2 <= WS_UPB && WS_UPB + (size_t)MT * DFF * 2 <= WS_HALO, "up");
static_assert(WS_P1 + (size_t)MT * S1N * 4 <= WS_CKVB && WS_CKVB + (size_t)KVR * 1024 <= WS_KPEB && WS_KPEB + (size_t)KVR * 128 <= WS_QN, "mla small");

#define LAS __attribute__((address_space(3)))
#define GAS __attribute__((address_space(1)))
typedef unsigned short bf16;
typedef unsigned u32x4 __attribute__((ext_vector_type(4)));
typedef unsigned u32x2 __attribute__((ext_vector_type(2)));
typedef float f32x4 __attribute__((ext_vector_type(4)));
typedef float f32x2 __attribute__((ext_vector_type(2)));
typedef short bf16x8 __attribute__((ext_vector_type(8)));

typedef __bf16 bf16x2_t __attribute__((ext_vector_type(2)));
__device__ __forceinline__ unsigned pk2(float lo, float hi) { f32x2 v = {lo, hi}; bf16x2_t b = __builtin_convertvector(v, bf16x2_t); return __builtin_bit_cast(unsigned, b); }
__device__ __forceinline__ unsigned f2bf(float f) { return pk2(f, 0.f) & 0xffffu; }
#define LBAR() do { asm volatile("s_waitcnt lgkmcnt(0)" ::: "memory"); __builtin_amdgcn_s_barrier(); asm volatile("" ::: "memory"); } while (0)
__device__ __forceinline__ float bflo(unsigned w) { return __builtin_bit_cast(float, w << 16); }
__device__ __forceinline__ float bfhi(unsigned w) { return __builtin_bit_cast(float, w & 0xffff0000u); }
__device__ __forceinline__ float bf1(bf16 v) { return __builtin_bit_cast(float, (unsigned)v << 16); }
__device__ __forceinline__ float wave_sum(float v) {
#pragma unroll
    for (int o = 1; o < 64; o <<= 1) v += __shfl_xor(v, o);
    return v;
}
__device__ __forceinline__ float sigmoidf_(float x) { return __builtin_amdgcn_rcpf(1.0f + __expf(-x)); }
__device__ __forceinline__ float siluf_(float x) { return x * __builtin_amdgcn_rcpf(1.0f + __expf(-x)); }
__device__ __forceinline__ int pos_index(int r) { return r < MP ? (r & (SEQP - 1)) : SEQP + ((r - MP) & 63); }
__device__ __forceinline__ int kv_row(int r) { return r < MP ? r : MP + ((r - MP) >> 6) * KVS + PAST + ((r - MP) & 63); }

namespace pg8 {
#define PG8_LAS __attribute__((address_space(3)))
typedef unsigned short bf16_t;
typedef short bf16x8 __attribute__((ext_vector_type(8)));
typedef float f32x4 __attribute__((ext_vector_type(4)));
typedef unsigned u32x4 __attribute__((ext_vector_type(4)));
constexpr int BM = 256, BK = 64, HALF = 128, HTB = HALF * BK * 2  , STAGE_BYTES = 8 * HTB, NXCD = 8, WGM = 8;

__host__ __device__ __forceinline__ int lds_byte(int r, int c) { const int st = (r >> 4) * 2 + (c >> 5), rr = r & 15, cc = c & 31, ob = rr * 64 + cc * 2; return st * 1024 + (ob ^ (((ob >> 9) & 1) << 5)); }
__host__ __device__ __forceinline__ void stage_rc(int b, int& R, int& C) { const int st = b / 1024, sb = b % 1024, swz = sb ^ (((sb >> 9) & 1) << 5); R = (st >> 1) * 16 + swz / 64; C = (st & 1) * 32 + (swz % 64) / 2; }
__host__ __device__ __forceinline__ int perm32(int rho) { const int n = rho >> 4, i = rho & 15; return 8 * (i >> 2) + 4 * n + (i & 3); }

struct Unit { int pm, pn; };
struct Gemm { const bf16_t* A; const bf16_t* Bt; int M, N, K; int pitch = 0, pn_mod = 0, kslice = 0; };

struct StaticOrder {
    int nM, nN, nwg, G, c;
    __host__ __device__ void init(int M, int N, int G_, int c_) { nM = M / BM; nN = N / BM; nwg = nM * nN; G = G_; c = c_; }
    __host__ __device__ bool next(int i, Unit& u) const {
        const long L = (long)i * G + c; if (L >= nwg) return false;
        int wgid = (int)L; { const int q = nwg / NXCD, r = nwg % NXCD, xcd = wgid % NXCD, off = wgid / NXCD; wgid = (xcd < r ? xcd * (q + 1) : r * (q + 1) + (xcd - r) * q) + off; }
        const int nig = WGM * nN, gid = wgid / nig, fm = gid * WGM, gsz = (nM - fm) < WGM ? (nM - fm) : WGM;
        u.pm = fm + ((wgid % nig) % gsz); u.pn = (wgid % nig) / gsz; return true;
    }
    __device__ __forceinline__ void a_ready(const Unit&) const {}
    __device__ __forceinline__ void done(const Unit&) const {}
};

__device__ __forceinline__ unsigned cvt_pk_bf16(float lo, float hi) { return pk2(lo, hi); }
__device__ __forceinline__ u32x4 pack8(f32x4 v0, f32x4 v1) { u32x4 w; w.x = cvt_pk_bf16(v0[0], v0[1]); w.y = cvt_pk_bf16(v0[2], v0[3]); w.z = cvt_pk_bf16(v1[0], v1[1]); w.w = cvt_pk_bf16(v1[2], v1[3]); return w; }

struct EpiF32 {
    static constexpr bool PERM = false, AFTER_DRAIN = false;
    float* O; int ldc;
    __device__ __forceinline__ void operator()(const f32x4 (&acc)[2][2][4][2], const Unit& u, int wr, int wc, int fr, int fq) const {
        const int row0 = u.pm * BM + wr * 64 + fr, col0 = u.pn * BM + wc * 32 + 4 * fq;
#pragma unroll
        for (int ai = 0; ai < 2; ++ai)
#pragma unroll
            for (int m = 0; m < 4; ++m) { float* rowp = O + (size_t)(row0 + ai * HALF + m * 16) * ldc + col0;
#pragma unroll
                for (int bj = 0; bj < 2; ++bj)
#pragma unroll
                    for (int n = 0; n < 2; ++n) *(f32x4*)(rowp + bj * HALF + n * 16) = acc[ai][bj][m][n]; }
    }
};

template <int ACT, int HALO> struct EpiBf16S {
    static constexpr bool PERM = true, AFTER_DRAIN = false;
    bf16_t* O0; int ld0; int pn_split; bf16_t* O1; int ld1; bf16_t* halo; int ldh; float scale;
    __device__ __forceinline__ void operator()(const f32x4 (&acc)[2][2][4][2], const Unit& u, int wr, int wc, int fr, int fq) const {
        const int row0 = u.pm * BM + wr * 64 + fr;
        bf16_t* base; int ld, colt;
        if (u.pn < pn_split) { base = O0; ld = ld0; colt = u.pn * BM; } else { base = O1; ld = ld1; colt = (u.pn - pn_split) * BM; }
        const int col0 = colt + wc * 32 + 8 * fq, gcol0 = u.pn * BM + wc * 32 + 8 * fq;
#pragma unroll
        for (int ai = 0; ai < 2; ++ai)
#pragma unroll
            for (int m = 0; m < 4; ++m) { const int row = row0 + ai * HALF + m * 16; bf16_t* rowp = base + (size_t)row * ld + col0;
#pragma unroll
                for (int bj = 0; bj < 2; ++bj) { f32x4 v0 = acc[ai][bj][m][0], v1 = acc[ai][bj][m][1];
                    if (ACT == 1) {
#pragma unroll
                        for (int e = 0; e < 4; ++e) { v0[e] = sigmoidf_(v0[e]); v1[e] = sigmoidf_(v1[e]); } }
                    v0 = v0 * scale; v1 = v1 * scale;
                    const u32x4 w = pack8(v0, v1);
                    *(u32x4*)(rowp + bj * HALF) = w;
                    if (HALO > 0) { if (m == 3 && fr >= 16 - HALO) *(u32x4*)(halo + ((size_t)(row >> 6) * HALO + (fr - (16 - HALO))) * ldh + gcol0 + bj * HALF) = w; }
                } }
    }
};

struct EpiQ {
    static constexpr bool PERM = true, AFTER_DRAIN = false;
    bf16_t* QN; bf16_t* QPp; const float* tab;
    __device__ __forceinline__ void operator()(const f32x4 (&acc)[2][2][4][2], const Unit& u, int wr, int wc, int fr, int fq) const {
        const int row0 = u.pm * BM + wr * 64 + fr;
        if (u.pn < 8) {
            const int col0 = u.pn * BM + wc * 32 + 8 * fq;
#pragma unroll
            for (int ai = 0; ai < 2; ++ai)
#pragma unroll
                for (int m = 0; m < 4; ++m) { bf16_t* rowp = QN + (size_t)(row0 + ai * HALF + m * 16) * 2048 + col0;
#pragma unroll
                    for (int bj = 0; bj < 2; ++bj) *(u32x4*)(rowp + bj * HALF) = pack8(acc[ai][bj][m][0] * QSCALE, acc[ai][bj][m][1] * QSCALE); }
        } else {
            const int t = u.pn - 8, s = 4 * (wc & 1) + fq;
#pragma unroll
            for (int ai = 0; ai < 2; ++ai)
#pragma unroll
                for (int m = 0; m < 4; ++m) { const int row = row0 + ai * HALF + m * 16; const float* tp = tab + (size_t)pos_index(row) * 64 + 4 * s;
                    const f32x4 cs = *(const f32x4*)tp, sn = *(const f32x4*)(tp + 32);
#pragma unroll
                    for (int bj = 0; bj < 2; ++bj) { const int head = 4 * t + 2 * bj + (wc >> 1);
                        const f32x4 x1 = acc[ai][bj][m][0], x2 = acc[ai][bj][m][1];
                        const f32x4 o1 = (x1 * cs - x2 * sn) * QSCALE, o2 = (x1 * sn + x2 * cs) * QSCALE;
                        bf16_t* qp = QPp + (size_t)row * 1024 + head * 64 + 4 * s;
                        u32x2 w1, w2; w1.x = cvt_pk_bf16(o1[0], o1[1]); w1.y = cvt_pk_bf16(o1[2], o1[3]); w2.x = cvt_pk_bf16(o2[0], o2[1]); w2.y = cvt_pk_bf16(o2[2], o2[3]);
                        *(u32x2*)qp = w1; *(u32x2*)(qp + 32) = w2; } }
        }
    }
};

struct EpiMerge {
    static constexpr bool PERM = true, AFTER_DRAIN = false;
    bf16_t* O; const bf16_t* G; const bf16_t* OM;
    __device__ __forceinline__ void operator()(const f32x4 (&acc)[2][2][4][2], const Unit& u, int wr, int wc, int fr, int fq) const {
        const int row0 = u.pm * BM + wr * 64 + fr, col0 = u.pn * BM + wc * 32 + 8 * fq;
#pragma unroll
        for (int ai = 0; ai < 2; ++ai)
#pragma unroll
            for (int m = 0; m < 4; ++m) { const size_t row = (size_t)(row0 + ai * HALF + m * 16);
#pragma unroll
                for (int bj = 0; bj < 2; ++bj) { const int c = col0 + bj * HALF;
                    const u32x4 ga = *(const u32x4*)(G + row * 4096 + c), gb = *(const u32x4*)(G + row * 4096 + 2048 + c), om = *(const u32x4*)(OM + row * 2048 + c);
                    const f32x4 a0 = acc[ai][bj][m][0], a1 = acc[ai][bj][m][1];
                    u32x4 w;
                    w.x = cvt_pk_bf16(bflo(ga.x) * bflo(om.x) + bflo(gb.x) * a0[0], bfhi(ga.x) * bfhi(om.x) + bfhi(gb.x) * a0[1]);
                    w.y = cvt_pk_bf16(bflo(ga.y) * bflo(om.y) + bflo(gb.y) * a0[2], bfhi(ga.y) * bfhi(om.y) + bfhi(gb.y) * a0[3]);
                    w.z = cvt_pk_bf16(bflo(ga.z) * bflo(om.z) + bflo(gb.z) * a1[0], bfhi(ga.z) * bfhi(om.z) + bfhi(gb.z) * a1[1]);
                    w.w = cvt_pk_bf16(bflo(ga.w) * bflo(om.w) + bflo(gb.w) * a1[2], bfhi(ga.w) * bfhi(om.w) + bfhi(gb.w) * a1[3]);
                    *(u32x4*)(O + row * 2048 + c) = w; } }
    }
};


struct EpiGateMerge {
    static constexpr bool PERM = true, AFTER_DRAIN = false;
    bf16_t* O; const bf16_t* OM; const bf16_t* OS;
    __device__ __forceinline__ void operator()(const f32x4 (&acc)[2][2][4][2], const Unit& u, int wr, int wc, int fr, int fq) const {
        const int row0 = u.pm * BM + wr * 64 + fr, c = u.pn * HALF + wc * 32 + 8 * fq;
#pragma unroll
        for (int ai = 0; ai < 2; ++ai)
#pragma unroll
            for (int m = 0; m < 4; ++m) { const size_t row = (size_t)(row0 + ai * HALF + m * 16);
                const u32x4 om = *(const u32x4*)(OM + row * 2048 + c), os = *(const u32x4*)(OS + row * 2048 + c);
                const f32x4 a0 = acc[ai][0][m][0], a1 = acc[ai][0][m][1], b0 = acc[ai][1][m][0], b1 = acc[ai][1][m][1];
                u32x4 w;
                w.x = pk2(sigmoidf_(a0[0]) * bflo(om.x) + sigmoidf_(b0[0]) * bflo(os.x), sigmoidf_(a0[1]) * bfhi(om.x) + sigmoidf_(b0[1]) * bfhi(os.x));
                w.y = pk2(sigmoidf_(a0[2]) * bflo(om.y) + sigmoidf_(b0[2]) * bflo(os.y), sigmoidf_(a0[3]) * bfhi(om.y) + sigmoidf_(b0[3]) * bfhi(os.y));
                w.z = pk2(sigmoidf_(a1[0]) * bflo(om.z) + sigmoidf_(b1[0]) * bflo(os.z), sigmoidf_(a1[1]) * bfhi(om.z) + sigmoidf_(b1[1]) * bfhi(os.z));
                w.w = pk2(sigmoidf_(a1[2]) * bflo(om.w) + sigmoidf_(b1[2]) * bflo(os.w), sigmoidf_(a1[3]) * bfhi(om.w) + sigmoidf_(b1[3]) * bfhi(os.w));
                *(u32x4*)(O + row * 2048 + c) = w; }
    }
};
template <class Epi, class Sched, bool ALIGN_EPI = false, bool SP2 = false>
__device__ __forceinline__ void gemm_phase(PG8_LAS unsigned char* lds, const Gemm g, const Sched& S, const Epi& E) {
    const int tid = threadIdx.x, wid = __builtin_amdgcn_readfirstlane(tid >> 6), lane = tid & 63, wr = wid >> 2, wc = wid & 3, fr = lane & 15, fq = lane >> 4;
    const int nt = g.K / BK; const int K = g.pitch ? g.pitch : g.K;
    unsigned voffA[2], voffB[2];
#pragma unroll
    for (int i = 0; i < 2; ++i) { int R, C; stage_rc(tid * 16 + i * 8192, R, C); const int Rb = Epi::PERM ? ((R & ~31) + perm32(R & 31)) : R;
        voffA[i] = (unsigned)(R * K + C) * 2u; voffB[i] = (unsigned)(Rb * K + C) * 2u; }
    const size_t kstep = (size_t)(BK * 2);
    const size_t hstep = (size_t)HALF * K * 2;
    const size_t tstep = 2 * hstep;
    const unsigned ldsw = (unsigned)wid * 1024u;
    const int aoff = lds_byte(wr * 64 + fr, fq * 8), boff = lds_byte(wc * 32 + fr, fq * 8);
#define PG8_SA(b, h) (((b) * 2 + (h)) * HTB)
#define PG8_SB(b, h) ((4 + (b) * 2 + (h)) * HTB)
#define PG8_STAGE(bufoff, gbase, voff) do { _Pragma("unroll") for (int _i = 0; _i < 2; ++_i) \
        __builtin_amdgcn_global_load_lds((const unsigned*)((const char*)(gbase) + (voff)[_i]), (PG8_LAS unsigned*)(lds + (bufoff) + ldsw + _i * 8192), 16, 0, 0); } while (0)
#define PG8_LDA(dst, b, h) do { _Pragma("unroll") for (int m = 0; m < 4; ++m) _Pragma("unroll") for (int k = 0; k < 2; ++k) dst[m][k] = *(const PG8_LAS bf16x8*)(lds + PG8_SA(b, h) + aoff + m * 2048 + k * 1024); } while (0)
#define PG8_LDB(dst, b, h) do { _Pragma("unroll") for (int n = 0; n < 2; ++n) _Pragma("unroll") for (int k = 0; k < 2; ++k) dst[n][k] = *(const PG8_LAS bf16x8*)(lds + PG8_SB(b, h) + boff + n * 2048 + k * 1024); } while (0)
#define PG8_MMA(ai, bj, At, Bt) do { __builtin_amdgcn_s_setprio(1); _Pragma("unroll") for (int m = 0; m < 4; ++m) _Pragma("unroll") for (int n = 0; n < 2; ++n) _Pragma("unroll") for (int k = 0; k < 2; ++k) \
        acc[ai][bj][m][n] = __builtin_amdgcn_mfma_f32_16x16x32_bf16(Bt[n][k], At[m][k], acc[ai][bj][m][n], 0, 0, 0); __builtin_amdgcn_s_setprio(0); } while (0)
#define PG8_WAIT_V(n) asm volatile("s_waitcnt vmcnt(" #n ")" ::: "memory")
#define PG8_WAIT_L(n) asm volatile("s_waitcnt lgkmcnt(" #n ")" ::: "memory")
#define PG8_BAR __builtin_amdgcn_s_barrier()
#define PG8_SCHED __builtin_amdgcn_sched_barrier(0)
    Unit cur, nxt; int ui = 0;
    if (!S.next(0, cur)) return;
    f32x4 acc[2][2][4][2];
#pragma unroll
    for (int a = 0; a < 2; ++a)
#pragma unroll
        for (int b = 0; b < 2; ++b)
#pragma unroll
            for (int m = 0; m < 4; ++m)
#pragma unroll
                for (int n = 0; n < 2; ++n) acc[a][b][m][n] = (f32x4){0.f, 0.f, 0.f, 0.f};
    bf16x8 At[4][2], B0[2][2], B1[2][2];
#define PG8_UA(u_) ((const char*)g.A + (size_t)(u_).pm * tstep + (g.pn_mod ? (size_t)((u_).pn / g.pn_mod) * g.kslice * 2 : (size_t)0))
#define PG8_UB(u_) ((const char*)g.Bt + (g.pn_mod ? (size_t)((u_).pn % g.pn_mod) * tstep + (size_t)((u_).pn / g.pn_mod) * g.kslice * 2 : (size_t)(u_).pn * tstep))
    const char* cA = PG8_UA(cur); const char* cB = PG8_UB(cur);
    S.a_ready(cur);
    if constexpr (SP2) {
        PG8_STAGE(PG8_SB(0, 0), cB, voffB); PG8_STAGE(PG8_SB(0, 1), cB + hstep, voffB); PG8_STAGE(PG8_SA(0, 0), cA, voffA); PG8_STAGE(PG8_SA(0, 1), cA + hstep, voffA);
        if (wr == 1) PG8_BAR;
        PG8_WAIT_V(2); PG8_BAR;
        PG8_STAGE(PG8_SB(1, 0), cB + kstep, voffB); PG8_STAGE(PG8_SA(1, 0), cA + kstep, voffA); PG8_STAGE(PG8_SB(1, 1), cB + hstep + kstep, voffB);
        PG8_WAIT_V(6); PG8_BAR;
    } else {
        PG8_STAGE(PG8_SB(0, 0), cB, voffB); PG8_STAGE(PG8_SA(0, 0), cA, voffA); PG8_STAGE(PG8_SB(0, 1), cB + hstep, voffB); PG8_STAGE(PG8_SA(0, 1), cA + hstep, voffA);
        if (wr == 1) PG8_BAR;
        PG8_WAIT_V(4); PG8_BAR;
        PG8_STAGE(PG8_SB(1, 0), cB + kstep, voffB); PG8_STAGE(PG8_SA(1, 0), cA + kstep, voffA); PG8_STAGE(PG8_SB(1, 1), cB + hstep + kstep, voffB);
        PG8_WAIT_V(6); PG8_BAR;
    }
    for (;;) {
        const bool has_next = S.next(ui + 1, nxt);
        const char* nA = has_next ? PG8_UA(nxt) : cA; const char* nB = has_next ? PG8_UB(nxt) : cB;
        for (int t = 0; t < nt; t += 2) {
            const bool last = (t == nt - 2);
            const char* a1 = cA + (size_t)(t + 1) * kstep;
            const char* a2 = last ? nA : cA + (size_t)(t + 2) * kstep; const char* b2 = last ? nB : cB + (size_t)(t + 2) * kstep;
            const char* a3 = a2 + kstep; const char* b3 = b2 + kstep;
            if (last && has_next) S.a_ready(nxt);
            if constexpr (SP2) {
            PG8_LDB(B0, 0, 0); PG8_LDB(B1, 0, 1); PG8_SCHED; PG8_LDA(At, 0, 0); PG8_STAGE(PG8_SA(1, 1), a1 + hstep, voffA);
            PG8_WAIT_V(8); PG8_WAIT_L(0); PG8_BAR; PG8_MMA(0, 0, At, B0); PG8_MMA(0, 1, At, B1); PG8_BAR; PG8_SCHED;
            PG8_LDA(At, 0, 1); PG8_STAGE(PG8_SB(0, 0), b2, voffB); PG8_STAGE(PG8_SB(0, 1), b2 + hstep, voffB); PG8_STAGE(PG8_SA(0, 0), a2, voffA);
            PG8_WAIT_V(8); PG8_WAIT_L(0); PG8_BAR; PG8_MMA(1, 0, At, B0); PG8_MMA(1, 1, At, B1); PG8_BAR; PG8_SCHED;
            PG8_LDB(B0, 1, 0); PG8_LDB(B1, 1, 1); PG8_SCHED; PG8_LDA(At, 1, 0); PG8_STAGE(PG8_SA(0, 1), a2 + hstep, voffA);
            PG8_WAIT_V(8); PG8_WAIT_L(0); PG8_BAR; PG8_MMA(0, 0, At, B0); PG8_MMA(0, 1, At, B1); PG8_BAR; PG8_SCHED;
            PG8_LDA(At, 1, 1); PG8_STAGE(PG8_SB(1, 0), b3, voffB); PG8_STAGE(PG8_SB(1, 1), b3 + hstep, voffB); PG8_STAGE(PG8_SA(1, 0), a3, voffA);
            PG8_WAIT_V(8); PG8_WAIT_L(0); PG8_BAR; PG8_MMA(1, 0, At, B0); PG8_MMA(1, 1, At, B1); PG8_BAR; PG8_SCHED;
            } else {
            PG8_LDB(B0, 0, 0); PG8_SCHED; PG8_LDA(At, 0, 0); PG8_STAGE(PG8_SA(1, 1), a1 + hstep, voffA);
            PG8_WAIT_L(8); PG8_BAR; PG8_WAIT_L(0); PG8_MMA(0, 0, At, B0); PG8_BAR; PG8_SCHED;
            PG8_LDB(B1, 0, 1); PG8_STAGE(PG8_SB(0, 0), b2, voffB);
            PG8_BAR; PG8_WAIT_L(0); PG8_MMA(0, 1, At, B1); PG8_BAR;
            PG8_LDA(At, 0, 1); PG8_STAGE(PG8_SA(0, 0), a2, voffA);
            PG8_BAR; PG8_WAIT_L(0); PG8_MMA(1, 0, At, B0); PG8_BAR; PG8_SCHED;
            PG8_STAGE(PG8_SB(0, 1), b2 + hstep, voffB);
            PG8_WAIT_V(6); PG8_BAR; PG8_MMA(1, 1, At, B1); PG8_BAR;
            PG8_LDB(B0, 1, 0); PG8_SCHED; PG8_LDA(At, 1, 0); PG8_STAGE(PG8_SA(0, 1), a2 + hstep, voffA);
            PG8_WAIT_L(8); PG8_BAR; PG8_WAIT_L(0); PG8_MMA(0, 0, At, B0); PG8_BAR; PG8_SCHED;
            PG8_LDB(B1, 1, 1); PG8_STAGE(PG8_SB(1, 0), b3, voffB);
            PG8_BAR; PG8_WAIT_L(0); PG8_MMA(0, 1, At, B1); PG8_BAR;
            PG8_LDA(At, 1, 1); PG8_STAGE(PG8_SA(1, 0), a3, voffA);
            PG8_BAR; PG8_WAIT_L(0); PG8_MMA(1, 0, At, B0); PG8_BAR; PG8_SCHED;
            PG8_STAGE(PG8_SB(1, 1), b3 + hstep, voffB);
            PG8_WAIT_V(6); PG8_BAR; PG8_MMA(1, 1, At, B1); PG8_BAR;
            }
        }
        if constexpr (ALIGN_EPI) { if (wr == 0) PG8_BAR; }
        if constexpr (!Epi::AFTER_DRAIN) { E(acc, cur, wr, wc, fr, fq); S.done(cur); }
        if (!has_next) break;
#pragma unroll
        for (int a = 0; a < 2; ++a)
#pragma unroll
            for (int b = 0; b < 2; ++b)
#pragma unroll
                for (int m = 0; m < 4; ++m)
#pragma unroll
                    for (int n = 0; n < 2; ++n) acc[a][b][m][n] = (f32x4){0.f, 0.f, 0.f, 0.f};
        cur = nxt; cA = nA; cB = nB; ++ui;
        if constexpr (ALIGN_EPI) { if (wr == 1) PG8_BAR; }
    }
    PG8_WAIT_V(0);
    if constexpr (!ALIGN_EPI) { if (wr == 0) PG8_BAR; }
    PG8_BAR;
    if constexpr (Epi::AFTER_DRAIN) { E.fused(acc, cur, wr, wc, fr, fq, lds, wid, lane); S.done(cur); }
#undef PG8_UA
#undef PG8_UB
#undef PG8_SA
#undef PG8_SB
#undef PG8_STAGE
#undef PG8_LDA
#undef PG8_LDB
#undef PG8_MMA
#undef PG8_WAIT_V
#undef PG8_WAIT_L
#undef PG8_BAR
#undef PG8_SCHED
}
}
#define XB_TMO      128
#define XB_XCNT(j)  (256  + 64 * (j))
#define XB_XSUB(j)  (1280 + 64 * (j))
#define XB_XGEN(j)  (2304 + 64 * (j))
#define XB_TOP      3328
#define XB_TOPGEN   3392
#define XCD_BAR_WORDS 3456
#define XB_SPIN_CAP (1u << 18)

__device__ __forceinline__ unsigned xb_ld(unsigned* p)              { return __hip_atomic_load(p, __ATOMIC_RELAXED, __HIP_MEMORY_SCOPE_AGENT); }
__device__ __forceinline__ unsigned xb_add(unsigned* p, unsigned v) { return __hip_atomic_fetch_add(p, v, __ATOMIC_RELAXED, __HIP_MEMORY_SCOPE_AGENT); }
__device__ __forceinline__ unsigned xb_xcc_id() { return (unsigned)__builtin_amdgcn_s_getreg((3 << 11) | 20) & 0xFu; }
#define XB_SPIN(cond, bar) do { unsigned _sp = 0; while (cond) { __builtin_amdgcn_s_sleep(1); \
    if ((++_sp & 255u) == 0u) { if (xb_ld(&(bar)[XB_TMO])) break; if (_sp > XB_SPIN_CAP) { atomicAdd(&(bar)[XB_TMO], 1u); break; } } } } while (0)

struct XcdBarrier {
    unsigned* bar; unsigned x;
    volatile LAS unsigned* st;
};

__device__ __forceinline__ XcdBarrier xcd_barrier_post(unsigned* bar, volatile LAS unsigned* st) {
    XcdBarrier b; b.bar = bar; b.x = xb_xcc_id(); b.st = st;
    if (threadIdx.x == 0) (void)xb_add(&bar[XB_XCNT(b.x)], 1u);
    return b;
}
__device__ __forceinline__ void xcd_barrier_complete(unsigned* bar, unsigned x, unsigned& nloc, unsigned& nx) {
    const unsigned G = gridDim.x * gridDim.y * gridDim.z;
    unsigned sum, cnt, mine, sp = 0u;
    for (;;) {
        sum = 0u; cnt = 0u; mine = 0u;
#pragma unroll
        for (unsigned j = 0; j < 16; ++j) { const unsigned c = xb_ld(&bar[XB_XCNT(j)]); sum += c; cnt += (c > 0u) ? 1u : 0u; mine = (j == x) ? c : mine; }
        if (sum == G) break;
        __builtin_amdgcn_s_sleep(1);
        if ((++sp & 255u) == 0u) { if (xb_ld(&bar[XB_TMO])) break; if (sp > XB_SPIN_CAP) { atomicAdd(&bar[XB_TMO], 1u); break; } }
    }
    nloc = mine > 0u ? mine : 1u; nx = cnt > 0u ? cnt : 1u;
}

__device__ __forceinline__ void xcd_barrier(const XcdBarrier& b) {
    asm volatile("s_waitcnt vmcnt(0)" ::: "memory");
    __syncthreads();
    if (threadIdx.x == 0) {
        unsigned* bar = b.bar;
        __builtin_amdgcn_s_waitcnt(0);
        unsigned nloc = b.st[0], nx = b.st[1];
        if (nloc == 0u) { xcd_barrier_complete(bar, b.x, nloc, nx); b.st[0] = nloc; b.st[1] = nx; }
        const unsigned old = xb_add(&bar[XB_XSUB(b.x)], 1u);
        const unsigned gen = old / nloc;
        if (old + 1u == (gen + 1u) * nloc) {
            __builtin_amdgcn_fence(__ATOMIC_RELEASE, "agent");
            asm volatile("s_waitcnt vmcnt(0)" ::: "memory");
            const unsigned og = xb_add(&bar[XB_TOP], 1u);
            const unsigned tg = og / nx;
            if (og + 1u == (tg + 1u) * nx) xb_add(&bar[XB_TOPGEN], 1u);
            else XB_SPIN(xb_ld(&bar[XB_TOPGEN]) == tg, bar);
            __builtin_amdgcn_fence(__ATOMIC_ACQUIRE, "agent");
            xb_add(&bar[XB_XGEN(b.x)], 1u);
            asm volatile("s_waitcnt vmcnt(0)" ::: "memory");
        } else {
            XB_SPIN(xb_ld(&bar[XB_XGEN(b.x)]) == gen, bar);
            __builtin_amdgcn_fence(__ATOMIC_ACQUIRE, "agent");
            asm volatile("s_waitcnt vmcnt(0)" ::: "memory");
        }
    }
    __syncthreads();
}
constexpr int NWAVES = 8;
constexpr int RING_BYTES = 131072;
constexpr int LDS_BYTES = 163840;

struct Args {
    const float* in[29];
    float* out; unsigned char* ws;
    int ph_lo, ph_hi;
};

struct Frame {
    LAS unsigned char* lds;
    int tid, lane, wave, G;
    const float* const* in;
    float* out; unsigned char* ws;
};

__device__ __forceinline__ int dst_row(int mat, int n) {
    if (mat == 0) {
        if (n < OFF_Z) return n;
        if (n < OFF_XBC) return n - OFF_Z + S1N;
        if (n < OFF_DT) return n - OFF_XBC + S1N + 4096;
        if (n < OFF_GATE) return n - OFF_DT + 1088;
        const int g = n - OFF_GATE, c = g & 2047;
        return S1N + S2N + 256 * (c >> 7) + ((g >> 11) << 7) + (c & 127);
    }
    if (mat == 1) {
        const int h = n / 192, d = n - h * 192;
        if (d < 128) return h * 128 + d;
        const int i = d - 128, t = h >> 2, hh = h & 3;
        const int s = (i & 31) >> 2, e = (i & 3) + ((i >> 5) << 2);
        return 2048 + t * 256 + 8 * (hh * 8 + s) + e;
    }
    if (mat == 2) {
        const int h = n >> 8, d = n & 255;
        return d < 128 ? h * 128 + d : 2048 + h * 128 + (d - 128);
    }
    return n;
}
__device__ __forceinline__ void p0_transpose_item(const float* W, int K, int N, bf16* WT, int mat, const float* kscale, LAS float* scr, int item, int lane) {
    const int nblk = N / 32, kb = item / nblk, nb = item % nblk, k0 = 64 * kb, n0 = 32 * nb;
#pragma unroll 8
    for (int i = 0; i < 32; ++i) { const int kk = 2 * i + (lane >> 5); float v = __builtin_nontemporal_load(W + (size_t)(k0 + kk) * N + n0 + (lane & 31)); if (kscale) v *= kscale[k0 + kk]; scr[kk * 33 + (lane & 31)] = v; }
    asm volatile("s_waitcnt lgkmcnt(0)" ::: "memory");
    const int c = lane & 7;
#pragma unroll
    for (int j = 0; j < 4; ++j) { const int n = (lane >> 3) + 8 * j; const LAS float* s = scr + (8 * c) * 33 + n;
        u32x4 o; o.x = pk2(s[0 * 33], s[1 * 33]); o.y = pk2(s[2 * 33], s[3 * 33]); o.z = pk2(s[4 * 33], s[5 * 33]); o.w = pk2(s[6 * 33], s[7 * 33]);
        *(u32x4*)(WT + (size_t)dst_row(mat, n0 + n) * K + k0 + 8 * c) = o; }
    asm volatile("s_waitcnt lgkmcnt(0)" ::: "memory");
}
__device__ __forceinline__ void rms_row_bf16(const float* xrow, const float* g, bf16* orow, int lane) {
    const f32x4* xr = (const f32x4*)xrow + lane; const f32x4* gr = (const f32x4*)g + lane;
    f32x4 v[8]; float s = 0.f;
#pragma unroll
    for (int j = 0; j < 8; ++j) { v[j] = __builtin_nontemporal_load(xr + 64 * j); s += (v[j].x * v[j].x + v[j].y * v[j].y) + (v[j].z * v[j].z + v[j].w * v[j].w); }
    const float rstd = 1.0f / sqrtf(wave_sum(s) * (1.f / DM) + EPS);
    u32x2* o8 = (u32x2*)orow + lane;
#pragma unroll
    for (int j = 0; j < 8; ++j) { const f32x4 gg = gr[64 * j]; u32x2 w; w.x = pk2(v[j].x * rstd * gg.x, v[j].y * rstd * gg.y); w.y = pk2(v[j].z * rstd * gg.z, v[j].w * rstd * gg.w); o8[64 * j] = w; }
}
__device__ __forceinline__ const float* x_row(const Frame& F, int r) { return r < MP ? F.in[0] + (size_t)r * DM : F.in[1] + (size_t)(r - MP) * DM; }

__device__ __forceinline__ void p0_prologue(Frame& F) {
    LAS float* scr = (LAS float*)(F.lds + F.wave * 16384);
    const int gw = blockIdx.x * NWAVES + F.wave, NGW = F.G * NWAVES;
    constexpr int I0 = 32 * (IN_DIM / 32), I1 = 8 * 96, I2 = 8 * 128, I3 = 32 * 64, I4 = 64 * 64, I5 = 32 * 64, I6 = 32 * 352, I7 = 88 * 64;
    constexpr int NITEMS = I0 + I1 + I2 + I3 + I4 + I5;
    unsigned char* ws = F.ws;
    for (int it = gw; it < NITEMS; it += NGW) {
        int r = it;
        if (r < I0) { p0_transpose_item(F.in[8], 2048, IN_DIM, (bf16*)(ws + WS_WIN), 0, nullptr, scr, r, F.lane); continue; } r -= I0;
        if (r < I1) { p0_transpose_item(F.in[10], 512, 3072, (bf16*)(ws + WS_WUQ), 1, nullptr, scr, r, F.lane); continue; } r -= I1;
        if (r < I2) { p0_transpose_item(F.in[12], 512, 4096, (bf16*)(ws + WS_WUKV), 2, nullptr, scr, r, F.lane); continue; } r -= I2;
        if (r < I3) { p0_transpose_item(F.in[19], 2048, 2048, (bf16*)(ws + WS_WOMLA), 3, nullptr, scr, r, F.lane); continue; } r -= I3;
        if (r < I4) { p0_transpose_item(F.in[20], 4096, 2048, (bf16*)(ws + WS_WOSSD), 3, F.in[18], scr, r, F.lane); continue; } r -= I4;
        p0_transpose_item(F.in[21], 2048, 2048, (bf16*)(ws + WS_WOUT), 3, nullptr, scr, r, F.lane);
    }
    for (int m = gw; m < MT; m += NGW) rms_row_bf16(x_row(F, m), F.in[7], (bf16*)(ws + WS_U) + (size_t)m * DM, F.lane);
    { float* tab = (float*)(ws + WS_ROPE); const int gt = blockIdx.x * 512 + F.tid, NT = F.G * 512;
        for (int e = gt; e < (SEQP + LSAMP) * 32; e += NT) { const int pi = e >> 5, i = e & 31; const int pos = pi < SEQP ? pi : PAST + (pi - SEQP);
            const float inv = powf(10000.0f, -(float)i * (1.0f / 32.0f)); const float a = (float)pos * inv;
            tab[pi * 64 + i] = cosf(a); tab[pi * 64 + 32 + i] = sinf(a); } }
    { const int gt = blockIdx.x * 512 + F.tid, NT = F.G * 512;
        bf16* ckvb = (bf16*)(ws + WS_CKVB); bf16* kpeb = (bf16*)(ws + WS_KPEB);
        for (int e = gt; e < NBS * PAST * 128; e += NT) { const int row = e >> 7, c4 = e & 127; const int b = row / PAST, t = row - b * PAST;
            const f32x4 v = __builtin_nontemporal_load((const f32x4*)F.in[2] + (size_t)row * 128 + c4); u32x2 w; w.x = pk2(v.x, v.y); w.y = pk2(v.z, v.w);
            *((u32x2*)(ckvb + (size_t)(MP + b * KVS + t) * 512) + c4) = w; }
        for (int e = gt; e < NBS * PAST * 16; e += NT) { const int row = e >> 4, c4 = e & 15; const int b = row / PAST, t = row - b * PAST;
            const f32x4 v = *((const f32x4*)F.in[3] + (size_t)row * 16 + c4); u32x2 w; w.x = pk2(v.x, v.y); w.y = pk2(v.z, v.w);
            *((u32x2*)(kpeb + (size_t)(MP + b * KVS + t) * 64) + c4) = w; } }
}

__device__ __forceinline__ void p0b_ffn_weights(Frame& F, int wg, int nwg) {
    LAS float* scr = (LAS float*)(F.lds + F.wave * 16384);
    constexpr int I6 = 32 * 352, I7 = 88 * 64;
    for (int it = wg * NWAVES + F.wave; it < I6 + I7; it += nwg * NWAVES) {
        if (it < I6) p0_transpose_item(F.in[24], 2048, 2 * DFF, (bf16*)(F.ws + WS_WUP), 3, nullptr, scr, it, F.lane);
        else p0_transpose_item(F.in[27], DFF, 2048, (bf16*)(F.ws + WS_WDN), 3, nullptr, scr, it - I6, F.lane);
    }
}

__device__ __forceinline__ void p2_mla_prep(Frame& F) {
    const int gw = blockIdx.x * NWAVES + F.wave, NGW = F.G * NWAVES, lane = F.lane;
    unsigned char* ws = F.ws;
    const float* P1 = (const float*)(ws + WS_P1); const float* tab = (const float*)(ws + WS_ROPE);
    const f32x4* qg = (const f32x4*)F.in[9] + lane; const f32x4* kg = (const f32x4*)F.in[11] + lane;
    for (int r = gw; r < MT; r += NGW) {
        const float* row = P1 + (size_t)r * S1N;
        const f32x4 q0 = __builtin_nontemporal_load((const f32x4*)row + lane), q1 = __builtin_nontemporal_load((const f32x4*)row + 64 + lane);
        const f32x4 k0 = __builtin_nontemporal_load((const f32x4*)(row + 512) + lane), k1 = __builtin_nontemporal_load((const f32x4*)(row + 512) + 64 + lane);
        float sq = (q0.x * q0.x + q0.y * q0.y) + (q0.z * q0.z + q0.w * q0.w) + (q1.x * q1.x + q1.y * q1.y) + (q1.z * q1.z + q1.w * q1.w);
        float sk = (k0.x * k0.x + k0.y * k0.y) + (k0.z * k0.z + k0.w * k0.w) + (k1.x * k1.x + k1.y * k1.y) + (k1.z * k1.z + k1.w * k1.w);
        const float rq = 1.0f / sqrtf(wave_sum(sq) * (1.f / 512.f) + EPS), rk = 1.0f / sqrtf(wave_sum(sk) * (1.f / 512.f) + EPS);
        { const f32x4 g0 = qg[0], g1 = qg[64]; u32x2* o = (u32x2*)((bf16*)(ws + WS_CQN) + (size_t)r * 512) + lane;
            u32x2 w; w.x = pk2(q0.x * rq * g0.x, q0.y * rq * g0.y); w.y = pk2(q0.z * rq * g0.z, q0.w * rq * g0.w); o[0] = w;
            w.x = pk2(q1.x * rq * g1.x, q1.y * rq * g1.y); w.y = pk2(q1.z * rq * g1.z, q1.w * rq * g1.w); o[64] = w; }
        const int kr = kv_row(r);
        { const f32x4 g0 = kg[0], g1 = kg[64];
            const f32x4 c0 = {k0.x * rk * g0.x, k0.y * rk * g0.y, k0.z * rk * g0.z, k0.w * rk * g0.w}, c1 = {k1.x * rk * g1.x, k1.y * rk * g1.y, k1.z * rk * g1.z, k1.w * rk * g1.w};
            float* oc = r < MP ? F.out + O_CKV_P + (size_t)r * 512 : F.out + O_CKV_S + (size_t)(r - MP) * 512;
            __builtin_nontemporal_store(c0, (f32x4*)oc + lane); __builtin_nontemporal_store(c1, (f32x4*)oc + 64 + lane);
            u32x2* o = (u32x2*)((bf16*)(ws + WS_CKVB) + (size_t)kr * 512) + lane;
            u32x2 w; w.x = pk2(c0.x, c0.y); w.y = pk2(c0.z, c0.w); o[0] = w; w.x = pk2(c1.x, c1.y); w.y = pk2(c1.z, c1.w); o[64] = w; }
        { const int i = lane & 31; const float x1 = row[1024 + i], x2 = row[1056 + i]; const float* tp = tab + (size_t)pos_index(r) * 64;
            const float cs = tp[i], sn = tp[32 + i]; const float o = lane < 32 ? x1 * cs - x2 * sn : x1 * sn + x2 * cs;
            float* ok = r < MP ? F.out + O_KPE_P + (size_t)r * 64 : F.out + O_KPE_S + (size_t)(r - MP) * 64;
            ok[lane] = o; ((bf16*)(ws + WS_KPEB))[(size_t)kr * 64 + lane] = (bf16)f2bf(o); }
        { const float x = row[1088 + lane] + F.in[15][lane]; const float sp = x > 20.f ? x : log1pf(__expf(x)); ((float*)(ws + WS_DT))[(size_t)r * 64 + lane] = sp; }
    }
}

typedef float f32x16 __attribute__((ext_vector_type(16)));
typedef short v4i16_t __attribute__((ext_vector_type(4)));
constexpr int AT_KN = 0, AT_V = 16384, AT_KPE = 32768, AT_STAGE = 40960;
__device__ __forceinline__ void glds16(const void* gsrc, unsigned lds_dst) { unsigned keep;
    asm volatile("s_mov_b32 %0, m0\n\ts_mov_b32 m0, %2\n\ts_nop 0\n\tglobal_load_lds_dwordx4 %1, off\n\ts_mov_b32 m0, %0" : "=&s"(keep) : "v"(gsrc), "s"(lds_dst) : "memory"); }
__device__ __forceinline__ int offb(int row, int ch) { return 256 * row + 16 * (ch ^ (((row & 3) << 2) | ((row >> 2) & 3))); }
__device__ __forceinline__ int offp(int row, int ch) { return 128 * row + 16 * (ch ^ ((row >> 1) & 7)); }

template <int ST> __device__ __forceinline__ void attn_tile(LAS unsigned char* lds, const bf16x8 (&qr)[12], f32x16 (&o)[4], float& mrun, float& lrun,
                                                            int kbase, int xh, int pbase, int x2h, const int (&vlo)[4], int dv) {
    LAS unsigned char* sb = lds + ST * AT_STAGE;
    asm volatile("" : "+v"(dv), "+v"(x2h), "+v"(xh));
    int pa[4], vhi[4], ka[8];
#pragma unroll
    for (int s = 0; s < 8; ++s) ka[s] = kbase + 32 * (s ^ xh);
#pragma unroll
    for (int s = 0; s < 4; ++s) { pa[s] = pbase + 32 * (s ^ x2h); vhi[s] = vlo[s] + dv; }
    f32x16 p0, p1;
#pragma unroll
    for (int r = 0; r < 16; ++r) { p0[r] = 0.f; p1[r] = 0.f; }
#pragma unroll
    for (int s = 0; s < 8; ++s) {
        const bf16x8 a0 = *(const LAS bf16x8*)(sb + AT_KN + ka[s]), a1 = *(const LAS bf16x8*)(sb + AT_KN + 8192 + ka[s]);
        p0 = __builtin_amdgcn_mfma_f32_32x32x16_bf16(a0, qr[s], p0, 0, 0, 0); p1 = __builtin_amdgcn_mfma_f32_32x32x16_bf16(a1, qr[s], p1, 0, 0, 0);
    }
#pragma unroll
    for (int s = 0; s < 4; ++s) {
        const bf16x8 a0 = *(const LAS bf16x8*)(sb + AT_KPE + pa[s]), a1 = *(const LAS bf16x8*)(sb + AT_KPE + 4096 + pa[s]);
        p0 = __builtin_amdgcn_mfma_f32_32x32x16_bf16(a0, qr[8 + s], p0, 0, 0, 0); p1 = __builtin_amdgcn_mfma_f32_32x32x16_bf16(a1, qr[8 + s], p1, 0, 0, 0);
    }
    float mx = p0[0];
#pragma unroll
    for (int r = 1; r < 16; ++r) mx = fmaxf(mx, p0[r]);
#pragma unroll
    for (int r = 0; r < 16; ++r) mx = fmaxf(mx, p1[r]);
    mx = fmaxf(mx, __shfl_xor(mx, 32));
    const float mnew = fmaxf(mrun, mx), alpha = __builtin_amdgcn_exp2f(mrun - mnew);
    mrun = mnew;
    float ps = 0.f;
#pragma unroll
    for (int r = 0; r < 16; ++r) { p0[r] = __builtin_amdgcn_exp2f(p0[r] - mnew); p1[r] = __builtin_amdgcn_exp2f(p1[r] - mnew); ps += p0[r] + p1[r]; }
    lrun = lrun * alpha + ps;
#pragma unroll
    for (int b = 0; b < 4; ++b)
#pragma unroll
        for (int r = 0; r < 16; ++r) o[b][r] *= alpha;
#pragma unroll
    for (int ks = 0; ks < 4; ++ks) {
        u32x4 w;
        if (ks < 2) { w.x = pk2(p0[8 * ks + 0], p0[8 * ks + 1]); w.y = pk2(p0[8 * ks + 2], p0[8 * ks + 3]); w.z = pk2(p0[8 * ks + 4], p0[8 * ks + 5]); w.w = pk2(p0[8 * ks + 6], p0[8 * ks + 7]); }
        else { const int k2 = ks - 2; w.x = pk2(p1[8 * k2 + 0], p1[8 * k2 + 1]); w.y = pk2(p1[8 * k2 + 2], p1[8 * k2 + 3]); w.z = pk2(p1[8 * k2 + 4], p1[8 * k2 + 5]); w.w = pk2(p1[8 * k2 + 6], p1[8 * k2 + 7]); }
        const bf16x8 pf = __builtin_bit_cast(bf16x8, w);
#pragma unroll
        for (int b = 0; b < 4; ++b) {
            const v4i16_t lo = __builtin_amdgcn_ds_read_tr16_b64_v4i16((LAS v4i16_t*)(sb + AT_V + ks * 4096 + vlo[b]));
            const v4i16_t hi = __builtin_amdgcn_ds_read_tr16_b64_v4i16((LAS v4i16_t*)(sb + AT_V + ks * 4096 + vhi[b]));
            const bf16x8 af = {lo[0], lo[1], lo[2], lo[3], hi[0], hi[1], hi[2], hi[3]};
            o[b] = __builtin_amdgcn_mfma_f32_32x32x16_bf16(af, pf, o[b], 0, 0, 0);
        }
    }
}

__device__ __forceinline__ void attn_unit(LAS unsigned char* lds, const bf16* QN, const bf16* QP, const bf16* KN, const bf16* KPE, const bf16* V, bf16* O,
                                          int q_row0, int kv_row0, int h, int NT, int ntw, int tid, int wave, int lane) {
    const int r32 = lane & 31, hh = lane >> 5;
    bf16x8 qr[12];
    if (ntw > 0) {
        const bf16* qn = QN + (size_t)(q_row0 + 32 * wave + r32) * 2048 + h * 128 + 8 * hh;
        const bf16* qp = QP + (size_t)(q_row0 + 32 * wave + r32) * 1024 + h * 64 + 8 * hh;
#pragma unroll
        for (int s = 0; s < 8; ++s) qr[s] = *(const bf16x8*)(qn + 16 * s);
#pragma unroll
        for (int s = 0; s < 4; ++s) qr[8 + s] = *(const bf16x8*)(qp + 16 * s);
    }
    asm volatile("" : "+v"(qr[0]), "+v"(qr[1]), "+v"(qr[2]), "+v"(qr[3]), "+v"(qr[4]), "+v"(qr[5]), "+v"(qr[6]), "+v"(qr[7]), "+v"(qr[8]), "+v"(qr[9]), "+v"(qr[10]), "+v"(qr[11]));
    const bf16* knsrc = KN + (size_t)kv_row0 * 2048 + h * 128;
    const bf16* vsrc = V + (size_t)kv_row0 * 2048 + h * 128;
    const bf16* kpsrc = KPE + (size_t)kv_row0 * 64;
    const int rowA = wave * 4 + (lane >> 4), chA = (lane & 15) ^ ((((lane >> 4) & 3) << 2) | (wave & 3));
    const int rowP = wave * 8 + (lane >> 3), chP = (lane & 7) ^ ((rowP >> 1) & 7);
    const int koff = rowA * 2048 + chA * 8, poff = rowP * 64 + chP * 8;
    const unsigned ldsw = (unsigned)(uintptr_t)lds + (unsigned)wave * 1024u;
#define AT_DMA(kt, st) do { const bf16* kb_ = knsrc + (size_t)(kt) * 64 * 2048; const bf16* vb_ = vsrc + (size_t)(kt) * 64 * 2048; const bf16* pb_ = kpsrc + (size_t)(kt) * 64 * 64; \
        const unsigned l_ = (unsigned)__builtin_amdgcn_readfirstlane((int)(ldsw + (unsigned)((st) * AT_STAGE))); \
        glds16(kb_ + koff, l_ + AT_KN); glds16(kb_ + koff + 32 * 2048, l_ + AT_KN + 8192); \
        glds16(vb_ + koff, l_ + AT_V); glds16(vb_ + koff + 32 * 2048, l_ + AT_V + 8192); \
        glds16(pb_ + poff, l_ + AT_KPE); } while (0)
    __syncthreads();
    AT_DMA(0, 0);
    if (NT > 1) { AT_DMA(1, 1); asm volatile("s_waitcnt vmcnt(5)" ::: "memory"); } else { asm volatile("s_waitcnt vmcnt(0)" ::: "memory"); }
    __builtin_amdgcn_s_barrier(); asm volatile("" ::: "memory");
    f32x16 o[4];
#pragma unroll
    for (int b = 0; b < 4; ++b)
#pragma unroll
        for (int r = 0; r < 16; ++r) o[b][r] = 0.f;
    float mrun = -1e30f, lrun = 0.f;
    int vlo[4], kbase, xh, pbase, x2h, dv;
    { const int x = ((r32 & 3) << 2) | ((r32 >> 2) & 3), xl = x & 1; xh = x >> 1; kbase = 256 * r32 + 16 * (hh ^ xl);
      const int x2 = (r32 >> 1) & 7, x2l = x2 & 1; x2h = x2 >> 1; pbase = 128 * r32 + 16 * (hh ^ x2l);
      const int g1 = (lane >> 4) & 1, qq = (lane & 15) >> 2, pq = lane & 3, cbase = 2 * g1 + (pq >> 1);
#pragma unroll
      for (int b = 0; b < 4; ++b) vlo[b] = 256 * (4 * hh + qq) + 16 * ((4 * b + cbase) ^ ((qq << 2) | hh)) + 8 * (pq & 1);
      dv = 2048 + 16 * ((cbase ^ (hh + 2)) - (cbase ^ hh)); }
#define AT_STEP(k, ST) do { \
        if ((k) + 2 < NT) AT_DMA((k) + 2, ((ST) + 2) % 3); \
        if ((k) < ntw) attn_tile<ST>(lds, qr, o, mrun, lrun, kbase, xh, pbase, x2h, vlo, dv); \
        if ((k) + 2 < NT) { asm volatile("s_waitcnt vmcnt(5) lgkmcnt(0)" ::: "memory"); } else { asm volatile("s_waitcnt vmcnt(0) lgkmcnt(0)" ::: "memory"); } \
        __builtin_amdgcn_s_barrier(); asm volatile("" ::: "memory"); } while (0)
    for (int kt = 0; kt < NT; kt += 3) {
        AT_STEP(kt, 0);
        if (kt + 1 < NT) AT_STEP(kt + 1, 1);
        if (kt + 2 < NT) AT_STEP(kt + 2, 2);
    }
#undef AT_STEP
#undef AT_DMA
    if (ntw > 0) {
        const float lt = lrun + __shfl_xor(lrun, 32), inv = 1.0f / lt;
        bf16* orow = O + (size_t)(q_row0 + 32 * wave + r32) * 2048 + h * 128;
#pragma unroll
        for (int b = 0; b < 4; ++b)
#pragma unroll
            for (int rq = 0; rq < 4; ++rq) { u32x2 w; w.x = pk2(o[b][4 * rq] * inv, o[b][4 * rq + 1] * inv); w.y = pk2(o[b][4 * rq + 2] * inv, o[b][4 * rq + 3] * inv);
                *(u32x2*)(orow + 32 * b + 8 * rq + 4 * hh) = w; }
    }
}

__device__ __forceinline__ void p4_attention(Frame& F, bf16* Odummy) {
    unsigned char* ws = F.ws;
    const bf16* QN = (const bf16*)(ws + WS_QN); const bf16* QPp = (const bf16*)(ws + WS_QP); const bf16* KN = (const bf16*)(ws + WS_KN);
    const bf16* KPE = (const bf16*)(ws + WS_KPEB); const bf16* V = (const bf16*)(ws + WS_V); bf16* O = Odummy ? Odummy : (bf16*)(ws + WS_QN);
    const int bx = blockIdx.x; const int vcu = (F.G % 8 == 0) ? (bx % 8) * (F.G / 8) + bx / 8 : bx;
    for (int pr = vcu; pr < 1024; pr += F.G) {
        const int bh = pr >> 4, pp = pr & 15, b = bh >> 4, h = bh & 15;
#pragma unroll 1
        for (int i = 0; i < 2; ++i) { const int qb = i ? 31 - pp : pp;
            attn_unit(F.lds, QN, QPp, KN, KPE, V, O, b * SEQP + qb * 256, b * SEQP, h, 4 * (qb + 1), 4 * qb + (F.wave >> 1) + 1, F.tid, F.wave, F.lane); }
    }
    if (vcu >= NBS * NH && F.G > NBS * NH) { __syncthreads(); p0b_ffn_weights(F, vcu - NBS * NH, F.G - NBS * NH); }
    for (int su = vcu; su < NBS * NH; su += F.G) { const int b = su >> 4, h = su & 15;
        attn_unit(F.lds, QN, QPp, KN, KPE, V, O, MP + b * 64, MP + b * KVS, h, KVS / 64, F.wave < 2 ? KVS / 64 : 0, F.tid, F.wave, F.lane); }
    if (F.G <= NBS * NH) { __syncthreads(); p0b_ffn_weights(F, vcu, F.G); }
}

__device__ __forceinline__ void p6a_conv(Frame& F) {
    const int gw = blockIdx.x * NWAVES + F.wave, NGW = F.G * NWAVES, lane = F.lane;
    bf16* X = (bf16*)(F.ws + WS_XBC); const bf16* XH = (const bf16*)(F.ws + WS_XH);
    const float* cw = F.in[13]; const float* cbv = F.in[14];
    constexpr int NCH = MT / 64, NSL = CONVD / 512;
    for (int u = gw; u < NCH * NSL; u += NGW) {
        const int ch = u / NSL, sl = u - ch * NSL, col = sl * 512 + lane * 8;
        float w[4][8], bs[8];
#pragma unroll
        for (int k = 0; k < 4; ++k) { const f32x4 a0 = *(const f32x4*)(cw + k * CONVD + col), a1 = *(const f32x4*)(cw + k * CONVD + col + 4);
#pragma unroll
            for (int e = 0; e < 4; ++e) { w[k][e] = a0[e]; w[k][4 + e] = a1[e]; } }
        { const f32x4 a0 = *(const f32x4*)(cbv + col), a1 = *(const f32x4*)(cbv + col + 4);
#pragma unroll
            for (int e = 0; e < 4; ++e) { bs[e] = a0[e]; bs[4 + e] = a1[e]; } }
        float h3[8], h2[8], h1[8];
        const bool first = ch < MP / 64 ? ((ch & 127) == 0) : true;
        const bool last = ch < MP / 64 ? ((ch & 127) == 127) : true;
        if (first) {
            if (ch < MP / 64) {
#pragma unroll
                for (int e = 0; e < 8; ++e) { h3[e] = 0.f; h2[e] = 0.f; h1[e] = 0.f; }
            } else { const float* hs = F.in[4] + (size_t)(ch - MP / 64) * 3 * CONVD + col;
#pragma unroll
                for (int e = 0; e < 8; ++e) { h3[e] = hs[e]; h2[e] = hs[CONVD + e]; h1[e] = hs[2 * CONVD + e]; } }
        } else { const bf16* hp = XH + (size_t)(ch - 1) * 3 * CONVD + col;
            const u32x4 x0 = *(const u32x4*)hp, x1 = *(const u32x4*)(hp + CONVD), x2 = *(const u32x4*)(hp + 2 * CONVD);
#pragma unroll
            for (int e = 0; e < 4; ++e) { h3[2 * e] = bflo(x0[e]); h3[2 * e + 1] = bfhi(x0[e]); h2[2 * e] = bflo(x1[e]); h2[2 * e + 1] = bfhi(x1[e]); h1[2 * e] = bflo(x2[e]); h1[2 * e + 1] = bfhi(x2[e]); } }
        float* oc = nullptr;
        if (last) oc = (ch < MP / 64 ? F.out + O_SCONV_P + (size_t)(ch >> 7) * 3 * CONVD : F.out + O_SCONV_S + (size_t)(ch - MP / 64) * 3 * CONVD) + col;
        bf16* xp = X + (size_t)ch * 64 * CONVD + col;
        for (int tb = 0; tb < 64; tb += 8) {
            u32x4 rv[8];
#pragma unroll
            for (int i = 0; i < 8; ++i) rv[i] = *(const u32x4*)(xp + (size_t)(tb + i) * CONVD);
#pragma unroll
            for (int i = 0; i < 8; ++i) {
                float c0[8], o[8];
#pragma unroll
                for (int e = 0; e < 4; ++e) { c0[2 * e] = bflo(rv[i][e]); c0[2 * e + 1] = bfhi(rv[i][e]); }
#pragma unroll
                for (int e = 0; e < 8; ++e) { const float s = bs[e] + w[0][e] * h3[e] + w[1][e] * h2[e] + w[2][e] * h1[e] + w[3][e] * c0[e]; o[e] = siluf_(s); h3[e] = h2[e]; h2[e] = h1[e]; h1[e] = c0[e]; }
                u32x4 wv; wv.x = pk2(o[0], o[1]); wv.y = pk2(o[2], o[3]); wv.z = pk2(o[4], o[5]); wv.w = pk2(o[6], o[7]);
                *(u32x4*)(xp + (size_t)(tb + i) * CONVD) = wv;
                if (oc && tb + i >= 61) { float* o2 = oc + (size_t)(tb + i - 61) * CONVD;
#pragma unroll
                    for (int e = 0; e < 8; ++e) o2[e] = c0[e]; }
            }
        }
    }
}

constexpr int SD_BUF = 53248;
constexpr int SDB_XS = 0;
constexpr int SDB_XW = 9216;
constexpr int SDB_BS = 18432;
constexpr int SDB_CS = 35840;
constexpr int SD_MS = 2 * SD_BUF;
constexpr int SD_HS = SD_MS + 9216;
constexpr int SD_SSQ = SD_HS + 2 * 17408;
constexpr int SD_AW = SD_SSQ + 2048;
constexpr int SD_END = SD_AW + 8 * 512;
static_assert(SD_END <= LDS_BYTES, "ssd lds");

__device__ __forceinline__ bf16x8 tr8(const LAS unsigned char* p, int rowstride4) {
    const v4i16_t lo = __builtin_amdgcn_ds_read_tr16_b64_v4i16((LAS v4i16_t*)p), hi = __builtin_amdgcn_ds_read_tr16_b64_v4i16((LAS v4i16_t*)(p + rowstride4));
    return (bf16x8){lo[0], lo[1], lo[2], lo[3], hi[0], hi[1], hi[2], hi[3]};
}
__device__ __forceinline__ f32x4 mm16(const LAS unsigned char* A, int lda, const LAS unsigned char* B, int ldb, int nks, f32x4 acc, int lane) {
    const LAS unsigned char* a = A + (lane & 15) * lda + (lane >> 4) * 16; const LAS unsigned char* b = B + (lane & 15) * ldb + (lane >> 4) * 16;
#pragma unroll
    for (int ks = 0; ks < nks; ++ks) acc = __builtin_amdgcn_mfma_f32_16x16x32_bf16(*(const LAS bf16x8*)(a + ks * 64), *(const LAS bf16x8*)(b + ks * 64), acc, 0, 0, 0);
    return acc;
}
__device__ __forceinline__ f32x4 mm16_ta(const LAS unsigned char* At, int lda, const LAS unsigned char* B, int ldb, int nks, f32x4 acc, int lane) {
    const int i = lane & 15, kq = lane >> 4;
    const LAS unsigned char* a = At + (8 * kq + (i >> 2)) * lda + (i & 3) * 8; const LAS unsigned char* b = B + i * ldb + kq * 16;
#pragma unroll
    for (int ks = 0; ks < nks; ++ks) acc = __builtin_amdgcn_mfma_f32_16x16x32_bf16(tr8(a + ks * 32 * lda, 4 * lda), *(const LAS bf16x8*)(b + ks * 64), acc, 0, 0, 0);
    return acc;
}
__device__ __forceinline__ f32x4 mm16_tab(const LAS unsigned char* At, int lda, const LAS unsigned char* Bt, int ldb, int nks, f32x4 acc, int lane) {
    const int i = lane & 15, kq = lane >> 4;
    const LAS unsigned char* a = At + (8 * kq + (i >> 2)) * lda + (i & 3) * 8; const LAS unsigned char* b = Bt + (8 * kq + (i >> 2)) * ldb + (i & 3) * 8;
#pragma unroll
    for (int ks = 0; ks < nks; ++ks) acc = __builtin_amdgcn_mfma_f32_16x16x32_bf16(tr8(a + ks * 32 * lda, 4 * lda), tr8(b + ks * 32 * ldb, 4 * ldb), acc, 0, 0, 0);
    return acc;
}

struct SsdPre { u32x4 px, pb0, pb1, pc0, pc1; u32x2 zv[2]; float pdt; };
struct SsdCtx { const bf16* XBC; bf16* Z; const float* DT; float* SSQ; int row0, nchunks, h, cx, cb, cc; float Ah, Dh; };

struct SsdOff { unsigned x, b0, c0, dt, z0; };
__device__ __forceinline__ void ssd_load(const SsdCtx& X, const SsdOff& O, SsdPre& P, int c) {
    const size_t rb = (size_t)(X.row0 + c * 64);
    const char* xb = (const char*)(X.XBC + rb * CONVD); const char* db = (const char*)(X.DT + rb * 64); const char* zb = (const char*)(X.Z + rb * SSD_IN);
    P.px = *(const u32x4*)(xb + O.x);
    P.pb0 = *(const u32x4*)(xb + O.b0); P.pb1 = *(const u32x4*)(xb + O.b0 + 32 * CONVD * 2);
    P.pc0 = *(const u32x4*)(xb + O.c0); P.pc1 = *(const u32x4*)(xb + O.c0 + 32 * CONVD * 2);
    P.pdt = *(const float*)(db + O.dt);
    P.zv[0] = *(const u32x2*)(zb + O.z0); P.zv[1] = *(const u32x2*)(zb + O.z0 + 32);
}

template <int CUR> __device__ __forceinline__ void ssd_chunk(LAS unsigned char* L, const SsdCtx& X, const SsdOff& O, SsdPre& P, f32x4 (&Hacc)[4], int c, int tid, int lane, int wave) {
    const int xr = tid >> 3, xc = tid & 7, br = tid >> 4, bc = tid & 15, kq = lane >> 4, l15 = lane & 15, ib = wave >> 1, pbk0 = 2 * (wave & 1), pb = wave >> 1, nb0 = 4 * (wave & 1);
    const int rbase = X.row0 + c * 64;
    LAS unsigned char* SB = L + CUR * SD_BUF;
    const float dtv = P.pdt; float acum = dtv * X.Ah;
#define DPP_ADD(ctrl, rmask) acum += __builtin_bit_cast(float, __builtin_amdgcn_update_dpp(0, __builtin_bit_cast(int, acum), ctrl, rmask, 0xf, false))
    DPP_ADD(0x111, 0xf); DPP_ADD(0x112, 0xf); DPP_ADD(0x114, 0xf); DPP_ADD(0x118, 0xf); DPP_ADD(0x142, 0xa); DPP_ADD(0x143, 0xc);
#undef DPP_ADD
    const float aL = __builtin_bit_cast(float, __builtin_amdgcn_readlane(__builtin_bit_cast(int, acum), 63));
    LAS float* AW = (LAS float*)(L + SD_AW + wave * 512); AW[lane] = acum; AW[64 + lane] = dtv;
    { const float sx = __shfl(dtv, xr) * __expf(aL - __shfl(acum, xr)); const u32x4 px = P.px;
        *(LAS u32x4*)(SB + SDB_XS + xr * 144 + xc * 16) = px;
        u32x4 w; w.x = pk2(bflo(px.x) * sx, bfhi(px.x) * sx); w.y = pk2(bflo(px.y) * sx, bfhi(px.y) * sx); w.z = pk2(bflo(px.z) * sx, bfhi(px.z) * sx); w.w = pk2(bflo(px.w) * sx, bfhi(px.w) * sx);
        *(LAS u32x4*)(SB + SDB_XW + xr * 144 + xc * 16) = w;
        *(LAS u32x4*)(SB + SDB_BS + br * 272 + bc * 16) = P.pb0; *(LAS u32x4*)(SB + SDB_BS + (br + 32) * 272 + bc * 16) = P.pb1;
        *(LAS u32x4*)(SB + SDB_CS + br * 272 + bc * 16) = P.pc0; *(LAS u32x4*)(SB + SDB_CS + (br + 32) * 272 + bc * 16) = P.pc1; }
    const u32x2 zv0 = P.zv[0], zv1 = P.zv[1];
    LBAR();
    if (c + 2 < X.nchunks) ssd_load(X, O, P, c + 2);
    {
        bf16x8 fc[4], fb[2][4], fxw[2], fbt[4][2];
        { const LAS unsigned char* pc = SB + SDB_CS + (16 * ib + l15) * 272 + kq * 16;
#pragma unroll
          for (int ks = 0; ks < 4; ++ks) fc[ks] = *(const LAS bf16x8*)(pc + ks * 64); }
#pragma unroll
        for (int q = 0; q < 2; ++q) { const LAS unsigned char* pbp = SB + SDB_BS + (16 * (2 * (wave & 1) + q) + l15) * 272 + kq * 16;
#pragma unroll
            for (int ks = 0; ks < 4; ++ks) fb[q][ks] = *(const LAS bf16x8*)(pbp + ks * 64); }
        { const LAS unsigned char* pa = SB + SDB_XW + 16 * pb * 2 + (8 * kq + (l15 >> 2)) * 144 + (l15 & 3) * 8;
#pragma unroll
          for (int ks = 0; ks < 2; ++ks) fxw[ks] = tr8(pa + ks * 32 * 144, 4 * 144); }
#pragma unroll
        for (int q = 0; q < 4; ++q) { const LAS unsigned char* pt = SB + SDB_BS + 16 * (nb0 + q) * 2 + (8 * kq + (l15 >> 2)) * 272 + (l15 & 3) * 8;
#pragma unroll
            for (int ks = 0; ks < 2; ++ks) fbt[q][ks] = tr8(pt + ks * 32 * 272, 4 * 272); }
        const float dec = __expf(aL);
        f32x4 cbacc[2];
#pragma unroll
        for (int q = 0; q < 2; ++q) { cbacc[q] = (f32x4){0.f, 0.f, 0.f, 0.f};
#pragma unroll
            for (int ks = 0; ks < 4; ++ks) cbacc[q] = __builtin_amdgcn_mfma_f32_16x16x32_bf16(fb[q][ks], fc[ks], cbacc[q], 0, 0, 0); }
#pragma unroll
        for (int q = 0; q < 4; ++q) { f32x4 acc = Hacc[q] * dec;
#pragma unroll
            for (int ks = 0; ks < 2; ++ks) acc = __builtin_amdgcn_mfma_f32_16x16x32_bf16(fbt[q][ks], fxw[ks], acc, 0, 0, 0);
            Hacc[q] = acc; }
        const int i = 16 * ib + l15; const float ai = AW[i];
#pragma unroll
        for (int q = 0; q < 2; ++q) { const int j0 = 16 * (2 * (wave & 1) + q) + 4 * kq;
            const f32x4 aj = *(const LAS f32x4*)(AW + j0), dj = *(const LAS f32x4*)(AW + 64 + j0);
            float v[4];
#pragma unroll
            for (int r = 0; r < 4; ++r) v[r] = (j0 + r <= i) ? cbacc[q][r] * __expf(ai - aj[r]) * dj[r] : 0.f;
            u32x2 w; w.x = pk2(v[0], v[1]); w.y = pk2(v[2], v[3]);
            *(LAS u32x2*)(L + SD_MS + i * 144 + j0 * 2) = w; }
#pragma unroll
        for (int q = 0; q < 4; ++q) { u32x2 w; w.x = pk2(Hacc[q][0], Hacc[q][1]); w.y = pk2(Hacc[q][2], Hacc[q][3]);
            *(LAS u32x2*)(L + SD_HS + (CUR ^ 1) * 17408 + (16 * pb + l15) * 272 + (16 * (nb0 + q) + 4 * kq) * 2) = w; }
    }
    LBAR();
    {
        const int i = 16 * ib + l15; const float eai = __expf(AW[i]);
        bf16* zrow = (bf16*)((char*)(X.Z + (size_t)rbase * SSD_IN) + O.z0) - 16 * pbk0;
        bf16x8 fms[2], fcs[4], fxs[2][2], fhs[2][4];
        { const LAS unsigned char* pm = L + SD_MS + i * 144 + kq * 16; fms[0] = *(const LAS bf16x8*)pm; fms[1] = *(const LAS bf16x8*)(pm + 64);
          const LAS unsigned char* pc = SB + SDB_CS + i * 272 + kq * 16;
#pragma unroll
          for (int ks = 0; ks < 4; ++ks) fcs[ks] = *(const LAS bf16x8*)(pc + ks * 64); }
#pragma unroll
        for (int q = 0; q < 2; ++q) { const int pbk = pbk0 + q;
            const LAS unsigned char* pa = SB + SDB_XS + 16 * pbk * 2 + (8 * kq + (l15 >> 2)) * 144 + (l15 & 3) * 8;
            fxs[q][0] = tr8(pa, 4 * 144); fxs[q][1] = tr8(pa + 32 * 144, 4 * 144);
            const LAS unsigned char* ph = L + SD_HS + CUR * 17408 + (16 * pbk + l15) * 272 + kq * 16;
#pragma unroll
            for (int ks = 0; ks < 4; ++ks) fhs[q][ks] = *(const LAS bf16x8*)(ph + ks * 64); }
        u32x2 xs2[2];
#pragma unroll
        for (int q = 0; q < 2; ++q) xs2[q] = *(const LAS u32x2*)(SB + SDB_XS + i * 144 + (16 * (pbk0 + q) + 4 * kq) * 2);
        f32x4 a1[2], a2[2];
#pragma unroll
        for (int q = 0; q < 2; ++q) { a1[q] = (f32x4){0.f, 0.f, 0.f, 0.f}; a2[q] = (f32x4){0.f, 0.f, 0.f, 0.f};
#pragma unroll
            for (int ks = 0; ks < 2; ++ks) a1[q] = __builtin_amdgcn_mfma_f32_16x16x32_bf16(fxs[q][ks], fms[ks], a1[q], 0, 0, 0);
#pragma unroll
            for (int ks = 0; ks < 4; ++ks) a2[q] = __builtin_amdgcn_mfma_f32_16x16x32_bf16(fhs[q][ks], fcs[ks], a2[q], 0, 0, 0); }
#pragma unroll
        for (int q = 0; q < 2; ++q) { const int pbk = pbk0 + q; const u32x2 zz = q ? zv1 : zv0; const u32x2 xs = xs2[q];
            float y0 = a1[q][0] + eai * a2[q][0] + X.Dh * bflo(xs.x), y1 = a1[q][1] + eai * a2[q][1] + X.Dh * bfhi(xs.x), y2 = a1[q][2] + eai * a2[q][2] + X.Dh * bflo(xs.y), y3 = a1[q][3] + eai * a2[q][3] + X.Dh * bfhi(xs.y);
            y0 *= siluf_(bflo(zz.x)); y1 *= siluf_(bfhi(zz.x)); y2 *= siluf_(bflo(zz.y)); y3 *= siluf_(bfhi(zz.y));
            u32x2 w; w.x = pk2(y0, y1); w.y = pk2(y2, y3);
            *(u32x2*)(zrow + 16 * pbk) = w;
            float s = (y0 * y0 + y1 * y1) + (y2 * y2 + y3 * y3); s += __shfl_xor(s, 16); s += __shfl_xor(s, 32);
            if (kq == 0) ((LAS float*)(L + SD_SSQ + CUR * 1024))[i * 4 + pbk] = s; }
    }
    if (c > 0 && tid < 64) { const LAS float* sp = (const LAS float*)(L + SD_SSQ + (CUR ^ 1) * 1024) + tid * 4; X.SSQ[(size_t)(rbase - 64 + tid) * 64 + X.h] = (sp[0] + sp[1]) + (sp[2] + sp[3]); }
}

__device__ __forceinline__ void ssd_unit(Frame& F, int row0, int nchunks, int h, const float* h0, float* hout) {
    LAS unsigned char* L = F.lds; const int tid = F.tid, lane = F.lane, wave = F.wave;
    unsigned char* ws = F.ws;
    SsdCtx X; X.XBC = (const bf16*)(ws + WS_XBC); X.Z = (bf16*)(ws + WS_Z); X.DT = (const float*)(ws + WS_DT); X.SSQ = (float*)(ws + WS_SSQ);
    X.row0 = row0; X.nchunks = nchunks; X.h = h; X.cx = h * 64; X.cb = SSD_IN + (h >> 3) * 128; X.cc = SSD_IN + 1024 + (h >> 3) * 128;
    X.Ah = -__expf(F.in[16][h]); X.Dh = F.in[17][h];
    __syncthreads();
    f32x4 Hacc[4]; const int pb = wave >> 1, nb0 = 4 * (wave & 1), kq = lane >> 4, l15 = lane & 15;
#pragma unroll
    for (int q = 0; q < 4; ++q) {
#pragma unroll
        for (int r = 0; r < 4; ++r) { const int p = 16 * pb + l15, n = 16 * (nb0 + q) + 4 * kq + r; const float v = h0 ? h0[p * 128 + n] : 0.f; Hacc[q][r] = v;
            *((LAS bf16*)(L + SD_HS + p * 272) + n) = (bf16)f2bf(v); } }
    SsdOff O;
    { const int xr = tid >> 3, xc = tid & 7, br = tid >> 4, bc = tid & 15, ib = wave >> 1, pbk0 = 2 * (wave & 1);
      O.x = (unsigned)(xr * CONVD + X.cx + xc * 8) * 2u; O.b0 = (unsigned)(br * CONVD + X.cb + bc * 8) * 2u; O.c0 = (unsigned)(br * CONVD + X.cc + bc * 8) * 2u;
      O.dt = (unsigned)(lane * 64 + h) * 4u; O.z0 = (unsigned)((16 * ib + l15) * SSD_IN + h * 64 + 4 * kq + 16 * pbk0) * 2u; }
    SsdPre PA, PB;
    ssd_load(X, O, PA, 0);
    if (nchunks > 1) ssd_load(X, O, PB, 1);
    for (int c = 0; c < nchunks; c += 2) {
        ssd_chunk<0>(L, X, O, PA, Hacc, c, tid, lane, wave);
        if (c + 1 < nchunks) ssd_chunk<1>(L, X, O, PB, Hacc, c + 1, tid, lane, wave);
    }
    LBAR();
    if (tid < 64) { const LAS float* sp = (const LAS float*)(L + SD_SSQ + ((nchunks - 1) & 1) * 1024) + tid * 4; X.SSQ[(size_t)(row0 + (nchunks - 1) * 64 + tid) * 64 + h] = (sp[0] + sp[1]) + (sp[2] + sp[3]); }
#pragma unroll
    for (int q = 0; q < 4; ++q)
#pragma unroll
        for (int r = 0; r < 4; ++r) hout[(16 * pb + l15) * 128 + 16 * (nb0 + q) + 4 * kq + r] = Hacc[q][r];
}

__device__ __forceinline__ void p6_ssd(Frame& F) {
    const int bx = blockIdx.x; const int vcu = (F.G % 8 == 0) ? (bx % 8) * (F.G / 8) + bx / 8 : bx;
    for (int u = vcu; u < NBP * SSD_H; u += F.G) { const int b = u >> 6, h = u & 63;
        ssd_unit(F, b * SEQP, SEQP / 64, h, nullptr, F.out + O_SSD_P + (size_t)u * 8192); }
    for (int u = vcu; u < NBS * SSD_H; u += F.G) { const int b = u >> 6, h = u & 63;
        ssd_unit(F, MP + b * 64, 1, h, F.in[5] + (size_t)u * 8192, F.out + O_SSD_S + (size_t)u * 8192); }
}

__device__ __forceinline__ void p7_ynorm(Frame& F) {
    const int gw = blockIdx.x * NWAVES + F.wave, NGW = F.G * NWAVES, lane = F.lane;
    bf16* Y = (bf16*)(F.ws + WS_Z); const float* SSQ = (const float*)(F.ws + WS_SSQ);
    for (int r = gw; r < MT; r += NGW) {
        float s = SSQ[(size_t)r * 64 + lane];
        s += __shfl_xor(s, 1); s += __shfl_xor(s, 2); s += __shfl_xor(s, 4);
        const float rstd = 1.0f / sqrtf(s * (1.f / 512.f) + EPS);
        u32x4* yr = (u32x4*)(Y + (size_t)r * SSD_IN) + lane;
#pragma unroll
        for (int j = 0; j < 8; ++j) { const float rs = __shfl(rstd, 8 * j); u32x4 v = yr[64 * j];
            v.x = pk2(bflo(v.x) * rs, bfhi(v.x) * rs); v.y = pk2(bflo(v.y) * rs, bfhi(v.y) * rs); v.z = pk2(bflo(v.z) * rs, bfhi(v.z) * rs); v.w = pk2(bflo(v.w) * rs, bfhi(v.w) * rs);
            yr[64 * j] = v; }
    }
}
__device__ __forceinline__ void part_sum8(const float* part, int nsl, int r, int c, float (&v)[8]) {
    const float* p = part + (size_t)r * nsl * 2048 + c;
#pragma unroll
    for (int e = 0; e < 8; ++e) v[e] = 0.f;
    for (int sl = 0; sl < nsl; ++sl) { const f32x4 a = *(const f32x4*)(p + sl * 2048), b = *(const f32x4*)(p + sl * 2048 + 4);
#pragma unroll
        for (int e = 0; e < 4; ++e) { v[e] += a[e]; v[4 + e] += b[e]; } }
}
__device__ __forceinline__ void p9b_ossd_sample(Frame& F) {
    const int gw = blockIdx.x * NWAVES + F.wave, NGW = F.G * NWAVES, lane = F.lane;
    bf16* OS = (bf16*)(F.ws + WS_OSSD); const float* part = (const float*)(F.ws + WS_XH);
    for (int r = gw; r < MS; r += NGW) { const size_t row = (size_t)(MP + r);
#pragma unroll
        for (int j = 0; j < 4; ++j) { const int c = 512 * j + 8 * lane; float sv[8]; part_sum8(part, 8, r, c, sv);
            u32x4 w; w.x = pk2(sv[0], sv[1]); w.y = pk2(sv[2], sv[3]); w.z = pk2(sv[4], sv[5]); w.w = pk2(sv[6], sv[7]);
            *(u32x4*)(OS + row * 2048 + c) = w; }
    }
}
__device__ __forceinline__ void p10_x1(Frame& F) {
    const int gw = blockIdx.x * NWAVES + F.wave, NGW = F.G * NWAVES, lane = F.lane;
    const float* g1 = F.in[22]; const float* g2 = F.in[23];
    for (int r = gw; r < MT; r += NGW) {
        const u32x4* mr = (const u32x4*)((const bf16*)(F.ws + WS_Z) + (size_t)r * DM) + lane; const float* xr = x_row(F, r);
        float v[4][8]; float s = 0.f;
#pragma unroll
        for (int j = 0; j < 4; ++j) {
            if (r < MP) { const u32x4 m = __builtin_nontemporal_load(mr + 64 * j);
#pragma unroll
                for (int e = 0; e < 4; ++e) { v[j][2 * e] = bflo(m[e]); v[j][2 * e + 1] = bfhi(m[e]); } }
            else part_sum8((const float*)(F.ws + WS_XH), 8, r - MP, 512 * j + 8 * lane, v[j]);
#pragma unroll
            for (int e = 0; e < 8; ++e) s += v[j][e] * v[j][e]; }
        const float rstd = 1.0f / sqrtf(wave_sum(s) * (1.f / DM) + EPS);
        float s2 = 0.f;
#pragma unroll
        for (int j = 0; j < 4; ++j) { const int c = 512 * j + 8 * lane; const f32x4 x0 = __builtin_nontemporal_load((const f32x4*)(xr + c)), x1 = __builtin_nontemporal_load((const f32x4*)(xr + c + 4)), ga = *(const f32x4*)(g1 + c), gb = *(const f32x4*)(g1 + c + 4);
            f32x4 o0, o1;
#pragma unroll
            for (int e = 0; e < 4; ++e) { o0[e] = x0[e] + v[j][e] * rstd * ga[e]; o1[e] = x1[e] + v[j][4 + e] * rstd * gb[e]; v[j][e] = o0[e]; v[j][4 + e] = o1[e]; s2 += o0[e] * o0[e] + o1[e] * o1[e]; }
            u32x4 wx; wx.x = pk2(o0[0], o0[1]); wx.y = pk2(o0[2], o0[3]); wx.z = pk2(o1[0], o1[1]); wx.w = pk2(o1[2], o1[3]);
            *((u32x4*)(F.out + O_Y + (size_t)r * DM) + 64 * j + lane) = wx; }
        const float rstd2 = 1.0f / sqrtf(wave_sum(s2) * (1.f / DM) + EPS);
        u32x4* o8 = (u32x4*)((bf16*)(F.ws + WS_U) + (size_t)r * DM) + lane;
#pragma unroll
        for (int j = 0; j < 4; ++j) { const int c = 512 * j + 8 * lane; const f32x4 ga = *(const f32x4*)(g2 + c), gb = *(const f32x4*)(g2 + c + 4);
            u32x4 w; w.x = pk2(v[j][0] * rstd2 * ga[0], v[j][1] * rstd2 * ga[1]); w.y = pk2(v[j][2] * rstd2 * ga[2], v[j][3] * rstd2 * ga[3]);
            w.z = pk2(v[j][4] * rstd2 * gb[0], v[j][5] * rstd2 * gb[1]); w.w = pk2(v[j][6] * rstd2 * gb[2], v[j][7] * rstd2 * gb[3]); o8[64 * j] = w; }
    }
}
__device__ __forceinline__ void p12_convgate(Frame& F) {
    const int gw = blockIdx.x * NWAVES + F.wave, NGW = F.G * NWAVES, lane = F.lane;
    bf16* UA = (bf16*)(F.ws + WS_UPA); const bf16* UB = (const bf16*)(F.ws + WS_UPB); const bf16* HALO = (const bf16*)(F.ws + WS_HALO);
    const float* cw = F.in[25]; const float* cbv = F.in[26];
    constexpr int NCH = MT / 64, NSL = DFF / 512;
    for (int u = gw; u < NCH * NSL; u += NGW) {
        const int ch = u / NSL, sl = u - ch * NSL, col = sl * 512 + lane * 8;
        float wa[3][8], wb[3][8], ba[8], bb[8];
#pragma unroll
        for (int k = 0; k < 3; ++k) { const f32x4 a0 = *(const f32x4*)(cw + k * 2 * DFF + col), a1 = *(const f32x4*)(cw + k * 2 * DFF + col + 4), b0 = *(const f32x4*)(cw + k * 2 * DFF + DFF + col), b1 = *(const f32x4*)(cw + k * 2 * DFF + DFF + col + 4);
#pragma unroll
            for (int e = 0; e < 4; ++e) { wa[k][e] = a0[e]; wa[k][4 + e] = a1[e]; wb[k][e] = b0[e]; wb[k][4 + e] = b1[e]; } }
        { const f32x4 a0 = *(const f32x4*)(cbv + col), a1 = *(const f32x4*)(cbv + col + 4), b0 = *(const f32x4*)(cbv + DFF + col), b1 = *(const f32x4*)(cbv + DFF + col + 4);
#pragma unroll
            for (int e = 0; e < 4; ++e) { ba[e] = a0[e]; ba[4 + e] = a1[e]; bb[e] = b0[e]; bb[4 + e] = b1[e]; } }
        float a_m2[8], a_m1[8], b_m2[8], b_m1[8];
        const bool first = ch < MP / 64 ? ((ch & 127) == 0) : true;
        const bool last = ch < MP / 64 ? ((ch & 127) == 127) : true;
        if (first) {
            if (ch < MP / 64) {
#pragma unroll
                for (int e = 0; e < 8; ++e) { a_m2[e] = 0.f; a_m1[e] = 0.f; b_m2[e] = 0.f; b_m1[e] = 0.f; }
            } else { const float* hs = F.in[6] + (size_t)(ch - MP / 64) * 2 * 2 * DFF;
#pragma unroll
                for (int e = 0; e < 8; ++e) { a_m2[e] = hs[col + e]; a_m1[e] = hs[2 * DFF + col + e]; b_m2[e] = hs[DFF + col + e]; b_m1[e] = hs[2 * DFF + DFF + col + e]; } }
        } else { const bf16* hp = HALO + (size_t)(ch - 1) * 2 * 2 * DFF;
            const u32x4 x0 = *(const u32x4*)(hp + col), x1 = *(const u32x4*)(hp + 2 * DFF + col), y0 = *(const u32x4*)(hp + DFF + col), y1 = *(const u32x4*)(hp + 2 * DFF + DFF + col);
#pragma unroll
            for (int e = 0; e < 4; ++e) { a_m2[2 * e] = bflo(x0[e]); a_m2[2 * e + 1] = bfhi(x0[e]); a_m1[2 * e] = bflo(x1[e]); a_m1[2 * e + 1] = bfhi(x1[e]);
                b_m2[2 * e] = bflo(y0[e]); b_m2[2 * e + 1] = bfhi(y0[e]); b_m1[2 * e] = bflo(y1[e]); b_m1[2 * e + 1] = bfhi(y1[e]); } }
        float* oc = nullptr;
        if (last) oc = ch < MP / 64 ? F.out + O_FCONV_P + (size_t)(ch >> 7) * 2 * 2 * DFF : F.out + O_FCONV_S + (size_t)(ch - MP / 64) * 2 * 2 * DFF;
        for (int tb = 0; tb < 64; tb += 8) {
            u32x4 ra[8], rb[8];
#pragma unroll
            for (int i = 0; i < 8; ++i) { const size_t ro = (size_t)(ch * 64 + tb + i) * DFF + col; ra[i] = __builtin_nontemporal_load((const u32x4*)(UA + ro)); rb[i] = __builtin_nontemporal_load((const u32x4*)(UB + ro)); }
#pragma unroll
            for (int i = 0; i < 8; ++i) {
                const int t = tb + i; const size_t ro = (size_t)(ch * 64 + t) * DFF + col;
                float a0[8], b0[8]; u32x4 w;
#pragma unroll
                for (int e = 0; e < 4; ++e) { a0[2 * e] = bflo(ra[i][e]); a0[2 * e + 1] = bfhi(ra[i][e]); b0[2 * e] = bflo(rb[i][e]); b0[2 * e + 1] = bfhi(rb[i][e]); }
                float hv[8];
#pragma unroll
                for (int e = 0; e < 8; ++e) { const float ca = ba[e] + wa[0][e] * a_m2[e] + wa[1][e] * a_m1[e] + wa[2][e] * a0[e]; const float cb2 = bb[e] + wb[0][e] * b_m2[e] + wb[1][e] * b_m1[e] + wb[2][e] * b0[e];
                    hv[e] = siluf_(ca) * cb2; a_m2[e] = a_m1[e]; a_m1[e] = a0[e]; b_m2[e] = b_m1[e]; b_m1[e] = b0[e]; }
                w.x = pk2(hv[0], hv[1]); w.y = pk2(hv[2], hv[3]); w.z = pk2(hv[4], hv[5]); w.w = pk2(hv[6], hv[7]);
                *(u32x4*)(UA + ro) = w;
                if (oc && t >= 62) { float* o = oc + (size_t)(t - 62) * 2 * DFF + col;
#pragma unroll
                    for (int e = 0; e < 8; ++e) { o[e] = a0[e]; o[DFF + e] = b0[e]; } }
            }
        }
    }
}
__device__ __forceinline__ void p14_final(Frame& F) {
    const int gw = blockIdx.x * NWAVES + F.wave, NGW = F.G * NWAVES, lane = F.lane;
    const float* g1 = F.in[28];
    for (int r = gw; r < MT; r += NGW) {
        float* orow = F.out + O_Y + (size_t)r * DM; const u32x4* dr = (const u32x4*)((const bf16*)(F.ws + WS_DN) + (size_t)r * DM) + lane;
        u32x4 xq[4];
#pragma unroll
        for (int j = 0; j < 4; ++j) xq[j] = __builtin_nontemporal_load((const u32x4*)orow + 64 * j + lane);
        float v[4][8]; float s = 0.f;
#pragma unroll
        for (int j = 0; j < 4; ++j) {
            if (r < MP) { const u32x4 m = __builtin_nontemporal_load(dr + 64 * j);
#pragma unroll
                for (int e = 0; e < 4; ++e) { v[j][2 * e] = bflo(m[e]); v[j][2 * e + 1] = bfhi(m[e]); } }
            else part_sum8((const float*)(F.ws + WS_XH), 11, r - MP, 512 * j + 8 * lane, v[j]);
#pragma unroll
            for (int e = 0; e < 8; ++e) s += v[j][e] * v[j][e]; }
        const float rstd = 1.0f / sqrtf(wave_sum(s) * (1.f / DM) + EPS);
#pragma unroll
        for (int j = 0; j < 4; ++j) { const int c = 512 * j + 8 * lane; const f32x4 ga = *(const f32x4*)(g1 + c), gb = *(const f32x4*)(g1 + c + 4);
            const u32x4 xb = xq[j];
            f32x4 o0 = {bflo(xb.x), bfhi(xb.x), bflo(xb.y), bfhi(xb.y)}, o1 = {bflo(xb.z), bfhi(xb.z), bflo(xb.w), bfhi(xb.w)};
#pragma unroll
            for (int e = 0; e < 4; ++e) { o0[e] += v[j][e] * rstd * ga[e]; o1[e] += v[j][4 + e] * rstd * gb[e]; }
            __builtin_nontemporal_store(o0, (f32x4*)(orow + c)); __builtin_nontemporal_store(o1, (f32x4*)(orow + c + 4)); }
    }
}

#ifndef GEMM_REP
#define GEMM_REP 1
#endif
#ifndef GEMM_ALIGN
#define GEMM_ALIGN true
#endif
#ifndef GEMM_SP2
#define GEMM_SP2 true
#endif
constexpr int NPH = 16;
__global__ void __launch_bounds__(NWAVES * 64, 2) hybrid_fwd(Args args) {
    extern __shared__ __attribute__((aligned(16))) unsigned char lds_raw[];
    cg::grid_group grid = cg::this_grid();
    Frame F;
    F.lds = (LAS unsigned char*)lds_raw;
    F.tid = threadIdx.x; F.lane = F.tid & 63; F.wave = __builtin_amdgcn_readfirstlane(F.tid >> 6);
    F.G = gridDim.x; F.in = args.in; F.out = args.out; F.ws = args.ws;
    unsigned char* ws = args.ws;
    const int lo = args.ph_lo, hi = args.ph_hi;
    volatile LAS unsigned* bst = (volatile LAS unsigned*)(F.lds + LDS_BYTES - 64);
    if (F.tid == 0) { bst[0] = 0u; bst[1] = 0u; }
    __syncthreads();
    XcdBarrier xbar = xcd_barrier_post((unsigned*)ws, bst);
#define GSYNC() xcd_barrier(xbar)
#ifndef PHMASK
#define PHMASK 0xFFFF
#endif
#define IN(k) (((PHMASK >> (k)) & 1) && lo <= (k) && (k) < hi)
#define SEAM(k) do { if (IN(k) && IN((k) + 1)) GSYNC(); } while (0)
    if (hi < 0) grid.sync();
    using namespace pg8;
    const int bx = (int)blockIdx.x;
    if (IN(0)) { p0_prologue(F);
#if defined(PROBE_P0)
        __syncthreads(); p0_prologue(F);
#endif
    } SEAM(0);
    if (IN(1)) {
        Gemm g{(const bf16_t*)(ws + WS_U), (const bf16_t*)(ws + WS_WIN), MT, S1N, 2048}; StaticOrder S; S.init(MT, S1N, F.G, bx);
        EpiF32 E{(float*)(ws + WS_P1), S1N};
        gemm_phase<EpiF32, StaticOrder, GEMM_ALIGN, GEMM_SP2>(F.lds, g, S, E);
    } SEAM(1);
    if (IN(2)) { p2_mla_prep(F); } SEAM(2);
    if (IN(3)) {
        { Gemm g{(const bf16_t*)(ws + WS_CQN), (const bf16_t*)(ws + WS_WUQ), MT, 3072, 512}; StaticOrder S; S.init(MT, 3072, F.G, bx);
          EpiQ E{(bf16_t*)(ws + WS_QN), (bf16_t*)(ws + WS_QP), (const float*)(ws + WS_ROPE)};
          gemm_phase<EpiQ, StaticOrder, GEMM_ALIGN, GEMM_SP2>(F.lds, g, S, E); }
        { Gemm g{(const bf16_t*)(ws + WS_CKVB), (const bf16_t*)(ws + WS_WUKV), KVR, 4096, 512}; StaticOrder S; S.init(KVR, 4096, F.G, F.G - 1 - bx);
          EpiBf16S<0, 0> E{(bf16_t*)(ws + WS_KN), 2048, 8, (bf16_t*)(ws + WS_V), 2048, nullptr, 0, 1.0f};
          gemm_phase<EpiBf16S<0, 0>, StaticOrder, GEMM_ALIGN, GEMM_SP2>(F.lds, g, S, E); }
    } SEAM(3);
    if (IN(4)) {
#if defined(PROBE_ATT2)
        p4_attention(F, (bf16*)(F.out + O_Y));
#endif
        p4_attention(F, nullptr); } SEAM(4);
    if (IN(5)) {
        { Gemm g{(const bf16_t*)(ws + WS_QN), (const bf16_t*)(ws + WS_WOMLA), MT, 2048, 2048}; StaticOrder S; S.init(MT, 2048, F.G, bx);
          EpiBf16S<0, 0> E{(bf16_t*)(F.out + O_Y), 2048, 1 << 20, nullptr, 0, nullptr, 0, 1.0f};
          gemm_phase<EpiBf16S<0, 0>, StaticOrder, GEMM_ALIGN, GEMM_SP2>(F.lds, g, S, E); }
        { Gemm g{(const bf16_t*)(ws + WS_U), (const bf16_t*)(ws + WS_WIN) + (size_t)S1N * 2048, MT, 4096, 2048}; StaticOrder S; S.init(MT, 4096, F.G, F.G - 1 - bx);
          EpiBf16S<0, 0> E{(bf16_t*)(ws + WS_Z), 4096, 1 << 20, nullptr, 0, nullptr, 0, 1.0f};
          gemm_phase<EpiBf16S<0, 0>, StaticOrder, GEMM_ALIGN, GEMM_SP2>(F.lds, g, S, E); }
    } SEAM(5);
    if (IN(6)) {
        Gemm g{(const bf16_t*)(ws + WS_U), (const bf16_t*)(ws + WS_WIN) + (size_t)(S1N + 4096) * 2048, MT, 6144, 2048}; StaticOrder S; S.init(MT, 6144, F.G, bx);
        EpiBf16S<0, 3> E{(bf16_t*)(ws + WS_XBC), 6144, 1 << 20, nullptr, 0, (bf16_t*)(ws + WS_XH), 6144, 1.0f};
        gemm_phase<EpiBf16S<0, 3>, StaticOrder, GEMM_ALIGN, GEMM_SP2>(F.lds, g, S, E);
    } SEAM(6);
    if (IN(7)) { p6a_conv(F); GSYNC();
        p6_ssd(F); } SEAM(7);
    if (IN(8)) { p7_ynorm(F); } SEAM(8);
    if (IN(9)) {
        { Gemm g{(const bf16_t*)(ws + WS_Z), (const bf16_t*)(ws + WS_WOSSD), MP, 2048, 4096}; StaticOrder S; S.init(MP, 2048, F.G, bx);
          EpiBf16S<0, 0> E{(bf16_t*)(ws + WS_OSSD), 2048, 1 << 20, nullptr, 0, nullptr, 0, 1.0f};
          gemm_phase<EpiBf16S<0, 0>, StaticOrder, GEMM_ALIGN, GEMM_SP2>(F.lds, g, S, E); }
        { Gemm g{(const bf16_t*)(ws + WS_Z) + (size_t)MP * 4096, (const bf16_t*)(ws + WS_WOSSD), MS, 8 * 2048, 512, 4096, 8, 512}; StaticOrder S; S.init(MS, 8 * 2048, F.G, F.G - 1 - bx);
          EpiF32 E{(float*)(ws + WS_XH), 8 * 2048};
          gemm_phase<EpiF32, StaticOrder, GEMM_ALIGN, GEMM_SP2>(F.lds, g, S, E); }
    } SEAM(9);
    if (IN(10)) {
        p9b_ossd_sample(F); GSYNC();
        { Gemm g{(const bf16_t*)(ws + WS_U), (const bf16_t*)(ws + WS_WIN) + (size_t)(S1N + S2N) * 2048, MT, 4096, 2048}; StaticOrder S; S.init(MT, 4096, F.G, bx);
          EpiGateMerge E{(bf16_t*)(ws + WS_MRG), (const bf16_t*)(F.out + O_Y), (const bf16_t*)(ws + WS_OSSD)};
          gemm_phase<EpiGateMerge, StaticOrder, GEMM_ALIGN, GEMM_SP2>(F.lds, g, S, E); }
        GSYNC();
        { Gemm g{(const bf16_t*)(ws + WS_MRG), (const bf16_t*)(ws + WS_WOUT), MP, 2048, 2048}; StaticOrder S; S.init(MP, 2048, F.G, bx);
          EpiBf16S<0, 0> E{(bf16_t*)(ws + WS_Z), 2048, 1 << 20, nullptr, 0, nullptr, 0, 1.0f};
          gemm_phase<EpiBf16S<0, 0>, StaticOrder, GEMM_ALIGN, GEMM_SP2>(F.lds, g, S, E); }
        { Gemm g{(const bf16_t*)(ws + WS_MRG) + (size_t)MP * 2048, (const bf16_t*)(ws + WS_WOUT), MS, 8 * 2048, 256, 2048, 8, 256}; StaticOrder S; S.init(MS, 8 * 2048, F.G, F.G - 1 - bx);
          EpiF32 E{(float*)(ws + WS_XH), 8 * 2048};
          gemm_phase<EpiF32, StaticOrder, GEMM_ALIGN, GEMM_SP2>(F.lds, g, S, E); }
    } SEAM(10);
    if (IN(11)) { p10_x1(F); } SEAM(11);
    if (IN(12)) {
        Gemm g{(const bf16_t*)(ws + WS_U), (const bf16_t*)(ws + WS_WUP), MT, 2 * DFF, 2048}; StaticOrder S; S.init(MT, 2 * DFF, F.G, bx);
        EpiBf16S<0, 2> E{(bf16_t*)(ws + WS_UPA), DFF, DFF / 256, (bf16_t*)(ws + WS_UPB), DFF, (bf16_t*)(ws + WS_HALO), 2 * DFF, 1.0f};
        gemm_phase<EpiBf16S<0, 2>, StaticOrder, GEMM_ALIGN, GEMM_SP2>(F.lds, g, S, E);
    } SEAM(12);
    if (IN(13)) { p12_convgate(F); } SEAM(13);
    if (IN(14)) {
        { Gemm g{(const bf16_t*)(ws + WS_UPA), (const bf16_t*)(ws + WS_WDN), MP, 2048, DFF}; StaticOrder S; S.init(MP, 2048, F.G, bx);
          EpiBf16S<0, 0> E{(bf16_t*)(ws + WS_DN), 2048, 1 << 20, nullptr, 0, nullptr, 0, 1.0f};
          gemm_phase<EpiBf16S<0, 0>, StaticOrder, GEMM_ALIGN, GEMM_SP2>(F.lds, g, S, E); }
        { Gemm g{(const bf16_t*)(ws + WS_UPA) + (size_t)MP * DFF, (const bf16_t*)(ws + WS_WDN), MS, 11 * 2048, 512, DFF, 8, 512}; StaticOrder S; S.init(MS, 11 * 2048, F.G, F.G - 1 - bx);
          EpiF32 E{(float*)(ws + WS_XH), 11 * 2048};
          gemm_phase<EpiF32, StaticOrder, GEMM_ALIGN, GEMM_SP2>(F.lds, g, S, E); }
    } SEAM(14);
#if defined(PROBE_SYNC)
    for (int q_ = 0; q_ < 16; ++q_) GSYNC();
#endif
    if (IN(15)) { p14_final(F); }
#undef IN
#undef SEAM
}

extern "C" void kernel_launch(void* const* d_in, const int* in_sizes, int n_in, void* d_out, int out_size, void* d_ws, size_t ws_size, hipStream_t stream) {
    static int grid = 0;
    if (grid == 0) {
        if (n_in != 29 || (size_t)out_size != O_TOTAL || ws_size < WS_END) { fprintf(stderr, "kernel_launch: unexpected shapes: n_in %d out %d ws %zu (need >= %zu)\n", n_in, out_size, ws_size, (size_t)WS_END); grid = -1; return; }
        int dev = 0, cus = 0, per_cu = 0;
        if (hipGetDevice(&dev) != hipSuccess || hipDeviceGetAttribute(&cus, hipDeviceAttributeMultiprocessorCount, dev) != hipSuccess) { grid = -1; return; }
        if (hipFuncSetAttribute((const void*)hybrid_fwd, hipFuncAttributeMaxDynamicSharedMemorySize, LDS_BYTES) != hipSuccess) { fprintf(stderr, "kernel_launch: hipFuncSetAttribute failed\n"); grid = -1; return; }
        if (hipOccupancyMaxActiveBlocksPerMultiprocessor(&per_cu, (const void*)hybrid_fwd, NWAVES * 64, LDS_BYTES) != hipSuccess || per_cu < 1) { fprintf(stderr, "kernel_launch: occupancy query says %d\n", per_cu); per_cu = 1; }
        (void)hipGetLastError();
        grid = cus * 1;
    }
    if (grid < 0) return;
    if (hipMemsetAsync(d_ws, 0, 16384, stream) != hipSuccess) { fprintf(stderr, "kernel_launch: hipMemsetAsync failed\n"); return; }
    Args a{};
    for (int i = 0; i < 29; ++i) a.in[i] = (const float*)d_in[i];
    a.out = (float*)d_out; a.ws = (unsigned char*)d_ws;
#if defined(MK_MULTI)
    for (int p = 0; p < NPH; ++p) { a.ph_lo = p; a.ph_hi = p + 1; hipLaunchKernelGGL(hybrid_fwd, dim3(grid), dim3(NWAVES * 64), LDS_BYTES, stream, a); }
#else
    a.ph_lo = 0; a.ph_hi = NPH;
    void* kargs[] = {&a};
    hipError_t e = hipLaunchCooperativeKernel((const void*)hybrid_fwd, dim3(grid), dim3(NWAVES * 64), kargs, LDS_BYTES, stream);
    if (e != hipSuccess) fprintf(stderr, "kernel_launch: cooperative launch failed: %s (grid %d)\n", hipGetErrorString(e), grid);
#endif
}
```
